# Optimizing an MI355X kernel written in HIP

```python
import jax
import jax.numpy as jnp
from jax import lax
import numpy as np

D_MODEL = 1024
BATCH = 2
SEQ = 8192
DEPTH = 2
DEC_BATCH = 32
DEC_SEQ = 16
PAST_LEN = 4096

CHUNK = 64
N_EVEN = (DEPTH + 1) // 2
N_ODD = DEPTH // 2
HEAD_DIM = 64
N_Q_HEADS = 8
N_KV_HEADS = 2
Q_GROUP = N_Q_HEADS // N_KV_HEADS
WINDOW = 128
WIN_CHUNKS = -(-WINDOW // CHUNK)
SWA_ROWS = WIN_CHUNKS * CHUNK
BAND = (WIN_CHUNKS + 1) * CHUNK
ROPE_THETA = 10000.0
NEG = -1e30
D_LRU = 512
LRU_BLOCKS = 8
LRU_BW = D_LRU // LRU_BLOCKS
CONV_W = 4
LRU_C = 8.0
Q_W = N_Q_HEADS * HEAD_DIM
KV_W = N_KV_HEADS * HEAD_DIM
EVEN_IN = Q_W + 2 * KV_W + 2 * D_LRU
EVEN_MIX = Q_W + D_LRU
CHUNK_MLP = 128
D_C = D_MODEL
C_GROUPS = 8
C_GW = D_C // C_GROUPS
D_FF = 4 * D_MODEL
EPS = 1e-6

kernel_name = 'hybrid_swa_rglru_gmlp_stream_step'


def rms_norm(x, g):
    xf = x.astype(jnp.float32)
    y = xf * lax.rsqrt(jnp.mean(xf * xf, axis=-1, keepdims=True) + EPS)
    return (y * g.astype(jnp.float32)).astype(x.dtype)


def layer_norm(x, g):
    xf = x.astype(jnp.float32)
    xc = xf - jnp.mean(xf, axis=-1, keepdims=True)
    y = xc * lax.rsqrt(jnp.mean(xc * xc, axis=-1, keepdims=True) + EPS)
    return (y * g.astype(jnp.float32)).astype(x.dtype)


def rope(x, pos):
    half = HEAD_DIM // 2
    inv = ROPE_THETA ** (-jnp.arange(half, dtype=jnp.float32) / half)
    ang = pos.astype(jnp.float32)[:, None] * inv[None, :]
    cos = jnp.cos(ang)[None, :, None, :]
    sin = jnp.sin(ang)[None, :, None, :]
    xf = x.astype(jnp.float32)
    x1, x2 = xf[..., :half], xf[..., half:]
    return jnp.concatenate([x1 * cos - x2 * sin, x2 * cos + x1 * sin], axis=-1).astype(x.dtype)


def softmax_with_sink(s, sink):
    sk = sink.astype(jnp.float32)[:, :, None, None]
    m = jnp.maximum(jnp.max(s, axis=-1, keepdims=True), sk)
    e = jnp.exp(s - m)
    return e / (jnp.sum(e, axis=-1, keepdims=True) + jnp.exp(sk - m))


def swa_banded(q, k, v, sinks):
    bsz, s_len = q.shape[:2]
    nc = s_len // CHUNK
    pad = WIN_CHUNKS * CHUNK
    kp = jnp.pad(k, ((0, 0), (pad, 0), (0, 0), (0, 0)))
    vp = jnp.pad(v, ((0, 0), (pad, 0), (0, 0), (0, 0)))

    def band(t):
        return jnp.concatenate(
            [t[:, j * CHUNK:j * CHUNK + s_len].reshape(bsz, nc, CHUNK, N_KV_HEADS, HEAD_DIM)
             for j in range(WIN_CHUNKS + 1)], axis=2)

    kb, vb = band(kp), band(vp)
    qb = q.reshape(bsz, nc, CHUNK, N_KV_HEADS, Q_GROUP, HEAD_DIM)
    s = jnp.einsum('bcqkgd,bcskd->bckgqs', qb, kb, preferred_element_type=jnp.float32) * (HEAD_DIM ** -0.5)
    key_chunk = jnp.arange(nc)[:, None] - WIN_CHUNKS + jnp.arange(BAND)[None, :] // CHUNK
    s = jnp.where((key_chunk >= 0)[None, :, None, None, None, :], s, NEG)
    p = softmax_with_sink(s, sinks.reshape(N_KV_HEADS, Q_GROUP))
    o = jnp.einsum('bckgqs,bcskd->bcqkgd', p.astype(v.dtype), vb)
    return o.reshape(bsz, s_len, Q_W)


def swa_step(q, kk, vv, sinks):
    bsz, t = q.shape[:2]
    qg = q.reshape(bsz, t, N_KV_HEADS, Q_GROUP, HEAD_DIM)
    s = jnp.einsum('btkgd,bskd->bkgts', qg, kk, preferred_element_type=jnp.float32) * (HEAD_DIM ** -0.5)
    p = softmax_with_sink(s, sinks.reshape(N_KV_HEADS, Q_GROUP))
    o = jnp.einsum('bkgts,bskd->btkgd', p.astype(vv.dtype), vv)
    return o.reshape(bsz, t, Q_W)


def causal_conv(xr, buf, w, b):
    t = xr.shape[1]
    xp = jnp.concatenate([buf.astype(xr.dtype), xr], axis=1)
    y = xp[:, 0:t] * w[0] + b
    for i in range(1, CONV_W):
        y = y + xp[:, i:i + t] * w[i]
    return y, xp[:, -(CONV_W - 1):]


def rg_lru(xc, h0, wa, ba, wx, bx, lam):
    bsz, t, _ = xc.shape
    xb = xc.reshape(bsz, t, LRU_BLOCKS, LRU_BW)
    r = jax.nn.sigmoid(jnp.einsum('btnc,ncd->btnd', xb, wa).reshape(bsz, t, D_LRU) + ba)
    gi = jax.nn.sigmoid(jnp.einsum('btnc,ncd->btnd', xb, wx).reshape(bsz, t, D_LRU) + bx)
    log_a = -LRU_C * r.astype(jnp.float32) * jax.nn.softplus(-lam.astype(jnp.float32))
    a = jnp.exp(log_a)
    bterm = jnp.sqrt(-jnp.expm1(2.0 * log_a)) * (gi * xc).astype(jnp.float32)
    bterm = bterm.at[:, 0].add(a[:, 0] * h0.astype(jnp.float32))

    def combine(lhs, rhs):
        a1, b1 = lhs
        a2, b2 = rhs
        return a1 * a2, a2 * b1 + b2

    _, h = lax.associative_scan(combine, (a, bterm), axis=1)
    return h.astype(xc.dtype), h[:, -1].astype(h0.dtype)


def even_mixer(x, pos, k_cache, v_cache, h0, conv_buf, w_in, q_g, k_g, sinks,
               conv_w, conv_b, wa, ba, wx, bx, lam, w_out):
    bsz, t, _ = x.shape
    h = x @ w_in
    o1 = Q_W
    o2 = o1 + KV_W
    o3 = o2 + KV_W
    o4 = o3 + D_LRU
    q = h[..., :o1].reshape(bsz, t, N_Q_HEADS, HEAD_DIM)
    k = h[..., o1:o2].reshape(bsz, t, N_KV_HEADS, HEAD_DIM)
    v = h[..., o2:o3].reshape(bsz, t, N_KV_HEADS, HEAD_DIM)
    xr = h[..., o3:o4]
    gr = h[..., o4:]
    q = rope(rms_norm(q, q_g), pos)
    k = rope(rms_norm(k, k_g), pos)
    if k_cache is None:
        att = swa_banded(q, k, v, sinks)
        new_k, new_v = k[:, -SWA_ROWS:], v[:, -SWA_ROWS:]
        h0 = jnp.zeros((bsz, D_LRU), x.dtype)
        conv_buf = jnp.zeros((bsz, CONV_W - 1, D_LRU), x.dtype)
    else:
        rows = k_cache.shape[1]
        kk = jnp.concatenate([k_cache.astype(k.dtype), k], axis=1)
        vv = jnp.concatenate([v_cache.astype(v.dtype), v], axis=1)
        att = swa_step(q, kk, vv, sinks)
        new_k, new_v = kk[:, -rows:], vv[:, -rows:]
    xc, new_buf = causal_conv(xr, conv_buf, conv_w, conv_b)
    hs, new_h = rg_lru(xc, h0, wa, ba, wx, bx, lam)
    rec = hs * jax.nn.gelu(gr)
    out = jnp.concatenate([att, rec], axis=-1) @ w_out
    return out, new_k, new_v, new_h, new_buf


def gmlp_mixer(x, w_in, v_g, ws, bs, w_out):
    bsz, t, _ = x.shape
    z = jax.nn.gelu(x @ w_in)
    u = z[..., :D_C]
    v = layer_norm(z[..., D_C:], v_g)
    rows = min(t, CHUNK_MLP)
    nc = t // rows
    mask = jnp.tril(jnp.ones((rows, rows), dtype=bool))
    w = jnp.where(mask[None], ws[:, :rows, :rows], 0.0)
    vb = v.reshape(bsz, nc, rows, C_GROUPS, C_GW)
    sv = jnp.einsum('gts,bcsgw->bctgw', w.astype(v.dtype), vb) + bs[:, :rows].T[None, None, :, :, None]
    out = (u * sv.reshape(bsz, t, D_C)) @ w_out
    return out, v


def channel_mlp(x, w1, w2):
    return jnp.square(jax.nn.relu(x @ w1)) @ w2


def setup_inputs(seed: int = 0) -> dict:
    key = jax.random.key(seed)
    ks = iter(jax.random.split(key, 40))

    def nrm(shape, scale):
        return scale * jax.random.normal(next(ks), shape, jnp.float32)

    e, o = N_EVEN, N_ODD
    u = jax.random.uniform(next(ks), (e, D_LRU), jnp.float32, 0.9, 0.999)
    sg = u ** (1.0 / LRU_C)
    lam = jnp.log(sg) - jnp.log1p(-sg)
    return {
        'x_prompt': nrm((BATCH, SEQ, D_MODEL), 1.0),
        'x_sample': nrm((DEC_BATCH, DEC_SEQ, D_MODEL), 1.0),
        'cache_swa_k': nrm((e, DEC_BATCH, SWA_ROWS, N_KV_HEADS, HEAD_DIM), 1.0),
        'cache_swa_v': nrm((e, DEC_BATCH, SWA_ROWS, N_KV_HEADS, HEAD_DIM), 1.0),
        'state_lru_h': nrm((e, DEC_BATCH, D_LRU), 0.5),
        'state_lru_conv': nrm((e, DEC_BATCH, CONV_W - 1, D_LRU), 1.0),
        'e_norm_g': 1.0 + nrm((e, D_MODEL), 0.02),
        'e_w_in': nrm((e, D_MODEL, EVEN_IN), D_MODEL ** -0.5),
        'e_q_norm_g': 1.0 + nrm((e, HEAD_DIM), 0.02),
        'e_k_norm_g': 1.0 + nrm((e, HEAD_DIM), 0.02),
        'e_sinks': nrm((e, N_Q_HEADS), 0.5),
        'e_conv_w': nrm((e, CONV_W, D_LRU), CONV_W ** -0.5),
        'e_conv_b': nrm((e, D_LRU), 0.02),
        'e_gate_a_w': nrm((e, LRU_BLOCKS, LRU_BW, LRU_BW), LRU_BW ** -0.5),
        'e_gate_a_b': nrm((e, D_LRU), 0.02),
        'e_gate_x_w': nrm((e, LRU_BLOCKS, LRU_BW, LRU_BW), LRU_BW ** -0.5),
        'e_gate_x_b': nrm((e, D_LRU), 0.02),
        'e_lru_lambda': lam,
        'e_w_out': nrm((e, EVEN_MIX, D_MODEL), EVEN_MIX ** -0.5),
        'o_norm_g': 1.0 + nrm((o, D_MODEL), 0.02),
        'o_w_in': nrm((o, D_MODEL, 2 * D_C), D_MODEL ** -0.5),
        'o_v_norm_g': 1.0 + nrm((o, D_C), 0.02),
        'o_spatial_w': nrm((o, C_GROUPS, CHUNK_MLP, CHUNK_MLP), CHUNK_MLP ** -0.5),
        'o_spatial_b': 1.0 + nrm((o, C_GROUPS, CHUNK_MLP), 0.02),
        'o_w_out': nrm((o, D_C, D_MODEL), D_C ** -0.5),
        'ffn_norm_g': 1.0 + nrm((DEPTH, D_MODEL), 0.02),
        'ffn_w1': nrm((DEPTH, D_MODEL, D_FF), D_MODEL ** -0.5),
        'ffn_w2': nrm((DEPTH, D_FF, D_MODEL), D_FF ** -0.5),
    }


def reference(x_prompt, x_sample, cache_swa_k, cache_swa_v, state_lru_h, state_lru_conv,
              e_norm_g, e_w_in, e_q_norm_g, e_k_norm_g, e_sinks, e_conv_w, e_conv_b,
              e_gate_a_w, e_gate_a_b, e_gate_x_w, e_gate_x_b, e_lru_lambda, e_w_out,
              o_norm_g, o_w_in, o_v_norm_g, o_spatial_w, o_spatial_b, o_w_out,
              ffn_norm_g, ffn_w1, ffn_w2):
    pos_p = jnp.arange(x_prompt.shape[1])
    pos_s = PAST_LEN + jnp.arange(x_sample.shape[1])
    yp, ys = x_prompt, x_sample
    kp_l, vp_l, hp_l, cp_l = [], [], [], []
    ks_l, vs_l, hs_l, cs_l = [], [], [], []
    gv_l = []
    for layer in range(DEPTH):
        if layer % 2 == 0:
            e = layer // 2
            ew = (e_w_in[e], e_q_norm_g[e], e_k_norm_g[e], e_sinks[e], e_conv_w[e], e_conv_b[e],
                  e_gate_a_w[e], e_gate_a_b[e], e_gate_x_w[e], e_gate_x_b[e], e_lru_lambda[e], e_w_out[e])
            mp, kpn, vpn, hpn, cpn = even_mixer(rms_norm(yp, e_norm_g[e]), pos_p, None, None, None, None, *ew)
            ms, ksn, vsn, hsn, csn = even_mixer(rms_norm(ys, e_norm_g[e]), pos_s, cache_swa_k[e], cache_swa_v[e],
                                                state_lru_h[e], state_lru_conv[e], *ew)
            kp_l.append(kpn)
            vp_l.append(vpn)
            hp_l.append(hpn)
            cp_l.append(cpn)
            ks_l.append(ksn)
            vs_l.append(vsn)
            hs_l.append(hsn)
            cs_l.append(csn)
        else:
            o = layer // 2
            ow = (o_w_in[o], o_v_norm_g[o], o_spatial_w[o], o_spatial_b[o], o_w_out[o])
            mp, _ = gmlp_mixer(rms_norm(yp, o_norm_g[o]), *ow)
            ms, vsn = gmlp_mixer(rms_norm(ys, o_norm_g[o]), *ow)
            gv_l.append(vsn)
        yp = yp + mp
        ys = ys + ms
        yp = yp + channel_mlp(rms_norm(yp, ffn_norm_g[layer]), ffn_w1[layer], ffn_w2[layer])
        ys = ys + channel_mlp(rms_norm(ys, ffn_norm_g[layer]), ffn_w1[layer], ffn_w2[layer])
    return (yp, ys,
            jnp.stack(kp_l), jnp.stack(vp_l), jnp.stack(hp_l), jnp.stack(cp_l),
            jnp.stack(ks_l), jnp.stack(vs_l), jnp.stack(hs_l), jnp.stack(cs_l),
            jnp.stack(gv_l))
```

```cpp
#include <hip/hip_runtime.h>
#include <cstdio>
#include <cstdint>
#include <cmath>

#define LAS __attribute__((address_space(3)))
#define GAS __attribute__((address_space(1)))
typedef unsigned short bf16_t;
typedef short bf16x8 __attribute__((ext_vector_type(8)));
typedef short s16x4 __attribute__((ext_vector_type(4)));
typedef float f32x4 __attribute__((ext_vector_type(4)));
typedef float f32x2 __attribute__((ext_vector_type(2)));
typedef float f32x16 __attribute__((ext_vector_type(16)));
typedef unsigned u32x4 __attribute__((ext_vector_type(4)));
typedef unsigned u32x2 __attribute__((ext_vector_type(2)));
typedef __bf16 bf16x2_t __attribute__((ext_vector_type(2)));

constexpr int D = 1024, SEQ = 8192, NB = 2, MP = NB * SEQ, DB = 32, DS = 16, MS = DB * DS, M = MP + MS;
constexpr int EIN = 1792, FF = 4096, DL = 512, PAST = 4096;
constexpr int C_K = 512, C_V = 640, C_XR = 768, C_GR = 1280;
constexpr float EPS = 1e-6f;
constexpr float SCQ = 0.125f * 1.4426950408889634f;
constexpr float LOG2E = 1.4426950408889634f;

constexpr size_t MiB = 1u << 20;
constexpr size_t WS_CTL = 0, CTL_ZERO_BYTES = 1 * MiB;
constexpr size_t WS_ROPE = 1 * MiB;
constexpr size_t WS_RS0 = 3 * MiB;
constexpr size_t WS_SP8 = WS_RS0 + 128 * 1024;
constexpr size_t WS_CARRY = WS_RS0 + 256 * 1024;
constexpr size_t WS_SSQ = 4 * MiB;
constexpr size_t WS_LNP = 5 * MiB + 512 * 1024;
constexpr size_t WS_W = 8 * MiB;
constexpr size_t WS_WIN_E = WS_W, WS_WOUT_E = WS_WIN_E + (size_t)EIN * D * 2, WS_W1A = WS_WOUT_E + (size_t)D * D * 2, WS_W2A = WS_W1A + (size_t)FF * D * 2,
                 WS_WIN_O = WS_W2A + (size_t)FF * D * 2, WS_WOUT_O = WS_WIN_O + (size_t)2 * D * D * 2, WS_W1B = WS_WOUT_O + (size_t)D * D * 2, WS_W2B = WS_W1B + (size_t)FF * D * 2,
                 WS_GATE = WS_W2B + (size_t)FF * D * 2, WS_SPW = WS_GATE + 16 * 4096 * 2, WS_W_END = WS_SPW + 8 * 128 * 128 * 2;
constexpr size_t WS_YA = 53 * MiB, WS_YB = 86 * MiB, WS_BIG = 119 * MiB, WS_END = 251 * MiB;
constexpr size_t WS_XB = WS_BIG, WS_H1 = WS_BIG + 33 * MiB, WS_AO = WS_BIG + 91 * MiB;
constexpr size_t WS_Z = WS_BIG, WS_AO2 = WS_BIG + 66 * MiB;
static_assert(WS_W_END <= WS_YA && WS_LNP + (size_t)M * 16 * 8 <= WS_W && WS_SSQ + (size_t)M * 64 <= WS_LNP && WS_YA + (size_t)M * D * 2 <= WS_YB && WS_YB + (size_t)M * D * 2 <= WS_BIG, "ws map");
static_assert(WS_H1 + (size_t)M * EIN * 2 <= WS_AO && WS_AO + (size_t)M * D * 2 <= WS_END && WS_BIG + (size_t)M * FF * 2 <= WS_END && WS_XB + (size_t)M * D * 2 <= WS_H1, "ws map 2");
static_assert(WS_CARRY + 2 * 32 * 512 * 8 <= WS_SSQ, "ws map 3");

__device__ __forceinline__ unsigned cvtpk(float lo, float hi) { f32x2 v = {lo, hi}; bf16x2_t b = __builtin_convertvector(v, bf16x2_t); return __builtin_bit_cast(unsigned, b); }
__device__ __forceinline__ float bflo(unsigned u) { return __uint_as_float(u << 16); }
__device__ __forceinline__ float bfhi(unsigned u) { return __uint_as_float(u & 0xffff0000u); }
__device__ __forceinline__ float gelu_t(float x) {
    const float u = x * (0.7978845608f + 0.0356774081f * x * x);
    const float e = __builtin_amdgcn_exp2f(-2.885390082f * u);
    return x * __builtin_amdgcn_rcpf(1.0f + e);
}
__device__ __forceinline__ float sigmoid_f(float z) { return __builtin_amdgcn_rcpf(1.0f + __builtin_amdgcn_exp2f(-LOG2E * z)); }

namespace pg8 {
constexpr int BM = 256, BK = 64, HALF = 128, HTB = HALF * BK * 2, STAGE_BYTES = 8 * HTB, NXCD = 8, WGM = 8;
__host__ __device__ __forceinline__ int lds_byte(int r, int c) { const int st = (r >> 4) * 2 + (c >> 5), rr = r & 15, cc = c & 31, ob = rr * 64 + cc * 2; return st * 1024 + (ob ^ (((ob >> 9) & 1) << 5)); }
__host__ __device__ __forceinline__ void stage_rc(int b, int& R, int& C) { const int st = b / 1024, sb = b % 1024, swz = sb ^ (((sb >> 9) & 1) << 5); R = (st >> 1) * 16 + swz / 64; C = (st & 1) * 32 + (swz % 64) / 2; }
__host__ __device__ __forceinline__ int perm32(int rho) { const int n = rho >> 4, i = rho & 15; return 8 * (i >> 2) + 4 * n + (i & 3); }
struct Unit { int pm, pn; };
struct Gemm { const bf16_t* A; const bf16_t* Bt; int M, N, K; };
struct StaticOrder {
    int nM, nN, nwg, G, c;
    __host__ __device__ void init(int M_, int N_, int G_, int c_) { nM = M_ / BM; nN = N_ / BM; nwg = nM * nN; G = G_; c = c_; }
    __host__ __device__ bool next(int i, Unit& u) const {
        const long L = (long)i * G + c; if (L >= nwg) return false;
        int wgid = (int)L; { const int q = nwg / NXCD, r = nwg % NXCD, xcd = wgid % NXCD, off = wgid / NXCD; wgid = (xcd < r ? xcd * (q + 1) : r * (q + 1) + (xcd - r) * q) + off; }
        const int nig = WGM * nN, gid = wgid / nig, fm = gid * WGM, gsz = (nM - fm) < WGM ? (nM - fm) : WGM;
        u.pm = fm + ((wgid % nig) % gsz); u.pn = (wgid % nig) / gsz; return true;
    }
    __device__ __forceinline__ void a_ready(const Unit&) const {}
    __device__ __forceinline__ void done(const Unit&) const {}
};

__device__ __forceinline__ int row_pos(int r) { return r < MP ? (r & (SEQ - 1)) : PAST + ((r - MP) & (DS - 1)); }

struct EpiIn {
    static constexpr int PERM = 2; static constexpr bool AFTER_DRAIN = false;
    bf16_t* H1; const float* rs0; const f32x4* rope; const float* qg; const float* kg; float* out;
    static constexpr size_t O_KP = (size_t)M * D, O_VP = O_KP + 32768, O_HP = O_VP + 32768, O_CP = O_HP + 1024, O_KS = O_CP + 3072, O_VS = O_KS + 524288, O_HS = O_VS + 524288, O_CS = O_HS + 16384, O_GV = O_CS + 49152;
    __device__ __forceinline__ void operator()(const f32x4 (&acc)[2][2][4][2], const Unit& u, int wr, int wc, int fr, int fq) const {
        const int pn = u.pn;
        const int kind = pn < 2 ? 0 : (pn == 2 ? (wc < 2 ? 1 : 2) : (pn < 5 ? 3 : 4));
        const int colb = pn * 256 + 64 * wc + 8 * fq;
        f32x4 g[2][2];
        if (kind <= 1) { const float* gp = (kind == 0 ? qg : kg) + 8 * fq;
#pragma unroll
            for (int bj = 0; bj < 2; ++bj)
#pragma unroll
                for (int n = 0; n < 2; ++n) g[bj][n] = *(const f32x4*)(gp + 32 * bj + 4 * n); }
        const float qs = kind == 0 ? SCQ : 1.0f;
#pragma unroll
        for (int ai = 0; ai < 2; ++ai)
#pragma unroll
            for (int m = 0; m < 4; ++m) {
                const int r = u.pm * BM + ai * HALF + wr * 64 + m * 16 + fr;
                const float rs = rs0[r];
                f32x4 x[2][2];
#pragma unroll
                for (int bj = 0; bj < 2; ++bj)
#pragma unroll
                    for (int n = 0; n < 2; ++n) x[bj][n] = acc[ai][bj][m][n] * rs;
                f32x4 of[2][2];
                if (kind <= 1) {
                    float ss = 0.f;
#pragma unroll
                    for (int bj = 0; bj < 2; ++bj)
#pragma unroll
                        for (int n = 0; n < 2; ++n) ss += (x[bj][n][0] * x[bj][n][0] + x[bj][n][1] * x[bj][n][1]) + (x[bj][n][2] * x[bj][n][2] + x[bj][n][3] * x[bj][n][3]);
                    ss += __shfl_xor(ss, 16); ss += __shfl_xor(ss, 32);
                    const float rinv = __builtin_amdgcn_rsqf(ss * (1.0f / 64.0f) + EPS);
                    const f32x4* cs = rope + (size_t)row_pos(r) * 16 + 4 * fq;
#pragma unroll
                    for (int n = 0; n < 2; ++n) {
                        const f32x4 c01 = cs[2 * n], c23 = cs[2 * n + 1];
                        const float co[4] = {c01[0], c01[2], c23[0], c23[2]}, si[4] = {c01[1], c01[3], c23[1], c23[3]};
#pragma unroll
                        for (int e = 0; e < 4; ++e) {
                            const float x1 = x[0][n][e] * rinv * g[0][n][e], x2 = x[1][n][e] * rinv * g[1][n][e];
                            of[0][n][e] = x1 * co[e] - x2 * si[e]; of[1][n][e] = x2 * co[e] + x1 * si[e];
                        }
                    }
                } else if (kind == 4) {
#pragma unroll
                    for (int bj = 0; bj < 2; ++bj)
#pragma unroll
                        for (int n = 0; n < 2; ++n)
#pragma unroll
                            for (int e = 0; e < 4; ++e) of[bj][n][e] = gelu_t(x[bj][n][e]);
                } else {
#pragma unroll
                    for (int bj = 0; bj < 2; ++bj)
#pragma unroll
                        for (int n = 0; n < 2; ++n) of[bj][n] = x[bj][n];
                }
                bf16_t* rowp = H1 + (size_t)r * EIN + colb;
#pragma unroll
                for (int bj = 0; bj < 2; ++bj) { u32x4 w; w.x = cvtpk(of[bj][0][0] * qs, of[bj][0][1] * qs); w.y = cvtpk(of[bj][0][2] * qs, of[bj][0][3] * qs); w.z = cvtpk(of[bj][1][0] * qs, of[bj][1][1] * qs); w.w = cvtpk(of[bj][1][2] * qs, of[bj][1][3] * qs);
                    *(u32x4*)(rowp + 32 * bj) = w; }
                if (kind == 1 || kind == 2) {
                    const int kh = wc & 1; float* dst = nullptr;
                    if (r < MP) { const int t = r & (SEQ - 1), b = r >> 13; if (t >= SEQ - 128) dst = out + (kind == 1 ? O_KP : O_VP) + ((size_t)(b * 128 + (t - (SEQ - 128))) * 2 + kh) * 64; }
                    else { const int rr = r - MP, b = rr >> 4, t = rr & 15; dst = out + (kind == 1 ? O_KS : O_VS) + ((size_t)(b * 128 + 112 + t) * 2 + kh) * 64; }
                    if (dst) {
#pragma unroll
                        for (int bj = 0; bj < 2; ++bj)
#pragma unroll
                            for (int n = 0; n < 2; ++n) *(f32x4*)(dst + 32 * bj + 8 * fq + 4 * n) = of[bj][n]; }
                } else if (kind == 3) {
                    const int ch = (pn - 3) * 256 + 64 * wc + 8 * fq; float* dst = nullptr;
                    if (r < MP) { const int t = r & (SEQ - 1), b = r >> 13; if (t >= SEQ - 3) dst = out + O_CP + (size_t)(b * 3 + (t - (SEQ - 3))) * 512 + ch; }
                    else { const int rr = r - MP, b = rr >> 4, t = rr & 15; if (t >= DS - 3) dst = out + O_CS + (size_t)(b * 3 + (t - (DS - 3))) * 512 + ch; }
                    if (dst) {
#pragma unroll
                        for (int bj = 0; bj < 2; ++bj)
#pragma unroll
                            for (int n = 0; n < 2; ++n) *(f32x4*)(dst + 32 * bj + 4 * n) = of[bj][n]; }
                }
            }
    }
};
template <bool RES_F32> struct EpiRes {
    static constexpr int PERM = 1; static constexpr bool AFTER_DRAIN = false;
    const float* xp; const float* xs; const bf16_t* rb; bf16_t* Y; float* ssq;
    __device__ __forceinline__ void operator()(const f32x4 (&acc)[2][2][4][2], const Unit& u, int wr, int wc, int fr, int fq) const {
        const int col0 = u.pn * BM + wc * 32 + 8 * fq;
#pragma unroll
        for (int ai = 0; ai < 2; ++ai)
#pragma unroll
            for (int m = 0; m < 4; ++m) {
                const int r = u.pm * BM + ai * HALF + wr * 64 + m * 16 + fr; float s = 0.f;
#pragma unroll
                for (int bj = 0; bj < 2; ++bj) {
                    f32x4 r0, r1;
                    if (RES_F32) { const float* p = (r < MP ? xp + (size_t)r * D : xs + (size_t)(r - MP) * D) + col0 + bj * HALF; r0 = *(const f32x4*)p; r1 = *(const f32x4*)(p + 4); }
                    else { const u32x4 w = *(const u32x4*)(rb + (size_t)r * D + col0 + bj * HALF); r0 = (f32x4){bflo(w.x), bfhi(w.x), bflo(w.y), bfhi(w.y)}; r1 = (f32x4){bflo(w.z), bfhi(w.z), bflo(w.w), bfhi(w.w)}; }
                    const f32x4 y0 = r0 + acc[ai][bj][m][0], y1 = r1 + acc[ai][bj][m][1];
                    s += (y0[0] * y0[0] + y0[1] * y0[1]) + (y0[2] * y0[2] + y0[3] * y0[3]) + (y1[0] * y1[0] + y1[1] * y1[1]) + (y1[2] * y1[2] + y1[3] * y1[3]);
                    u32x4 w; w.x = cvtpk(y0[0], y0[1]); w.y = cvtpk(y0[2], y0[3]); w.z = cvtpk(y1[0], y1[1]); w.w = cvtpk(y1[2], y1[3]);
                    *(u32x4*)(Y + (size_t)r * D + col0 + bj * HALF) = w;
                }
                s += __shfl_xor(s, 16); s += __shfl_xor(s, 32);
                if (fq == 0) ssq[(size_t)r * 16 + u.pn * 4 + wc] = s;
            }
    }
};
__device__ __forceinline__ float row_rs(const float* ssq, int r) {
    const f32x4* p = (const f32x4*)(ssq + (size_t)r * 16); const f32x4 a = p[0], b = p[1], c = p[2], d = p[3];
    const float s = ((a[0] + a[1]) + (a[2] + a[3])) + ((b[0] + b[1]) + (b[2] + b[3])) + ((c[0] + c[1]) + (c[2] + c[3])) + ((d[0] + d[1]) + (d[2] + d[3]));
    return __builtin_amdgcn_rsqf(s * (1.0f / D) + EPS);
}
template <int ACT> struct EpiAct {
    static constexpr int PERM = 1; static constexpr bool AFTER_DRAIN = false;
    const float* ssq; bf16_t* O; int ldc; f32x2* lnp;
    __device__ __forceinline__ void operator()(const f32x4 (&acc)[2][2][4][2], const Unit& u, int wr, int wc, int fr, int fq) const {
        const int col0 = u.pn * BM + wc * 32 + 8 * fq;
#pragma unroll
        for (int ai = 0; ai < 2; ++ai)
#pragma unroll
            for (int m = 0; m < 4; ++m) {
                const int r = u.pm * BM + ai * HALF + wr * 64 + m * 16 + fr; const float rs = row_rs(ssq, r); float s1 = 0.f, s2 = 0.f;
#pragma unroll
                for (int bj = 0; bj < 2; ++bj) {
                    f32x4 v0 = acc[ai][bj][m][0] * rs, v1 = acc[ai][bj][m][1] * rs;
#pragma unroll
                    for (int e = 0; e < 4; ++e) {
                        if (ACT == 0) { const float a = fmaxf(v0[e], 0.f), b = fmaxf(v1[e], 0.f); v0[e] = a * a; v1[e] = b * b; }
                        else { v0[e] = gelu_t(v0[e]); v1[e] = gelu_t(v1[e]); }
                    }
                    if (ACT == 1) { s1 += (v0[0] + v0[1]) + (v0[2] + v0[3]) + (v1[0] + v1[1]) + (v1[2] + v1[3]);
                        s2 += (v0[0] * v0[0] + v0[1] * v0[1]) + (v0[2] * v0[2] + v0[3] * v0[3]) + (v1[0] * v1[0] + v1[1] * v1[1]) + (v1[2] * v1[2] + v1[3] * v1[3]); }
                    u32x4 w; w.x = cvtpk(v0[0], v0[1]); w.y = cvtpk(v0[2], v0[3]); w.z = cvtpk(v1[0], v1[1]); w.w = cvtpk(v1[2], v1[3]);
                    *(u32x4*)(O + (size_t)r * ldc + col0 + bj * HALF) = w;
                }
                if (ACT == 1 && u.pn >= 4) { s1 += __shfl_xor(s1, 16); s1 += __shfl_xor(s1, 32); s2 += __shfl_xor(s2, 16); s2 += __shfl_xor(s2, 32);
                    if (fq == 0) lnp[(size_t)r * 16 + (u.pn - 4) * 4 + wc] = (f32x2){s1, s2}; }
            }
    }
};
struct EpiOut {
    static constexpr int PERM = 0; static constexpr bool AFTER_DRAIN = false;
    const bf16_t* rb; float* out;
    __device__ __forceinline__ void operator()(const f32x4 (&acc)[2][2][4][2], const Unit& u, int wr, int wc, int fr, int fq) const {
        const int col0 = u.pn * BM + wc * 32 + 4 * fq;
#pragma unroll
        for (int ai = 0; ai < 2; ++ai)
#pragma unroll
            for (int m = 0; m < 4; ++m) {
                const size_t off = (size_t)(u.pm * BM + ai * HALF + wr * 64 + m * 16 + fr) * D + col0;
#pragma unroll
                for (int bj = 0; bj < 2; ++bj)
#pragma unroll
                    for (int n = 0; n < 2; ++n) { const u32x2 w = *(const u32x2*)(rb + off + bj * HALF + n * 16);
                        const f32x4 rv = {bflo(w.x), bfhi(w.x), bflo(w.y), bfhi(w.y)}; *(f32x4*)(out + off + bj * HALF + n * 16) = rv + acc[ai][bj][m][n]; }
            }
    }
};

template <class Epi, class Sched, bool ALIGN_EPI = false, bool SP2 = false>
__device__ __forceinline__ void gemm_phase(LAS unsigned char* lds, const Gemm g, const Sched& S, const Epi& E) {
    const int tid = threadIdx.x, wid = __builtin_amdgcn_readfirstlane(tid >> 6), lane = tid & 63, wr = wid >> 2, wc = wid & 3, fr = lane & 15, fq = lane >> 4;
    const int K = g.K, nt = K / BK;
    unsigned voffA[2], voffB[2], voffB1[2];
#pragma unroll
    for (int i = 0; i < 2; ++i) { int R, C; stage_rc(tid * 16 + i * 8192, R, C);
        int Rb0, Rb1;
        if (Epi::PERM == 0) { Rb0 = R; Rb1 = HALF + R; }
        else if (Epi::PERM == 1) { Rb0 = (R & ~31) + perm32(R & 31); Rb1 = HALF + Rb0; }
        else { Rb0 = 64 * (R >> 5) + perm32(R & 31); Rb1 = Rb0 + 32; }
        voffA[i] = (unsigned)(R * K + C) * 2u; voffB[i] = (unsigned)(Rb0 * K + C) * 2u; voffB1[i] = (unsigned)(Rb1 * K + C) * 2u; }
    const size_t kstep = (size_t)(BK * 2);
    const size_t hstep = (size_t)HALF * K * 2;
    const size_t tstep = 2 * hstep;
    const unsigned ldsw = (unsigned)wid * 1024u;
    const int aoff = lds_byte(wr * 64 + fr, fq * 8), boff = lds_byte(wc * 32 + fr, fq * 8);
#define PG8_SA(b, h) (((b) * 2 + (h)) * HTB)
#define PG8_SB(b, h) ((4 + (b) * 2 + (h)) * HTB)
#define PG8_STAGE(bufoff, gbase, voff) do { _Pragma("unroll") for (int _i = 0; _i < 2; ++_i) \
        __builtin_amdgcn_global_load_lds((const unsigned*)((const char*)(gbase) + (voff)[_i]), (LAS unsigned*)(lds + (bufoff) + ldsw + _i * 8192), 16, 0, 0); } while (0)
#define PG8_LDA(dst, b, h) do { _Pragma("unroll") for (int m = 0; m < 4; ++m) _Pragma("unroll") for (int k = 0; k < 2; ++k) dst[m][k] = *(const LAS bf16x8*)(lds + PG8_SA(b, h) + aoff + m * 2048 + k * 1024); } while (0)
#define PG8_LDB(dst, b, h) do { _Pragma("unroll") for (int n = 0; n < 2; ++n) _Pragma("unroll") for (int k = 0; k < 2; ++k) dst[n][k] = *(const LAS bf16x8*)(lds + PG8_SB(b, h) + boff + n * 2048 + k * 1024); } while (0)
#define PG8_MMA(ai, bj, At, Bt) do { __builtin_amdgcn_s_setprio(1); _Pragma("unroll") for (int m = 0; m < 4; ++m) _Pragma("unroll") for (int n = 0; n < 2; ++n) _Pragma("unroll") for (int k = 0; k < 2; ++k) \
        acc[ai][bj][m][n] = __builtin_amdgcn_mfma_f32_16x16x32_bf16(Bt[n][k], At[m][k], acc[ai][bj][m][n], 0, 0, 0); __builtin_amdgcn_s_setprio(0); } while (0)
#define PG8_WAIT_V(n) asm volatile("s_waitcnt vmcnt(" #n ")" ::: "memory")
#define PG8_WAIT_L(n) asm volatile("s_waitcnt lgkmcnt(" #n ")" ::: "memory")
#define PG8_BAR __builtin_amdgcn_s_barrier()
#define PG8_SCHED __builtin_amdgcn_sched_barrier(0)
    Unit cur, nxt; int ui = 0;
    if (!S.next(0, cur)) return;
    f32x4 acc[2][2][4][2];
#pragma unroll
    for (int a = 0; a < 2; ++a)
#pragma unroll
        for (int b = 0; b < 2; ++b)
#pragma unroll
            for (int m = 0; m < 4; ++m)
#pragma unroll
                for (int n = 0; n < 2; ++n) acc[a][b][m][n] = (f32x4){0.f, 0.f, 0.f, 0.f};
    bf16x8 At[4][2], B0[2][2], B1[2][2];
    const char* cA = (const char*)g.A + (size_t)cur.pm * tstep; const char* cB = (const char*)g.Bt + (size_t)cur.pn * tstep;
    S.a_ready(cur);
    if constexpr (SP2) {
        PG8_STAGE(PG8_SB(0, 0), cB, voffB); PG8_STAGE(PG8_SB(0, 1), cB, voffB1); PG8_STAGE(PG8_SA(0, 0), cA, voffA); PG8_STAGE(PG8_SA(0, 1), cA + hstep, voffA);
        if (wr == 1) PG8_BAR;
        PG8_WAIT_V(2); PG8_BAR;
        PG8_STAGE(PG8_SB(1, 0), cB + kstep, voffB); PG8_STAGE(PG8_SA(1, 0), cA + kstep, voffA); PG8_STAGE(PG8_SB(1, 1), cB + kstep, voffB1);
        PG8_WAIT_V(6); PG8_BAR;
    } else {
        PG8_STAGE(PG8_SB(0, 0), cB, voffB); PG8_STAGE(PG8_SA(0, 0), cA, voffA); PG8_STAGE(PG8_SB(0, 1), cB, voffB1); PG8_STAGE(PG8_SA(0, 1), cA + hstep, voffA);
        if (wr == 1) PG8_BAR;
        PG8_WAIT_V(4); PG8_BAR;
        PG8_STAGE(PG8_SB(1, 0), cB + kstep, voffB); PG8_STAGE(PG8_SA(1, 0), cA + kstep, voffA); PG8_STAGE(PG8_SB(1, 1), cB + kstep, voffB1);
        PG8_WAIT_V(6); PG8_BAR;
    }
    for (;;) {
        const bool has_next = S.next(ui + 1, nxt);
        const char* nA = has_next ? (const char*)g.A + (size_t)nxt.pm * tstep : cA; const char* nB = has_next ? (const char*)g.Bt + (size_t)nxt.pn * tstep : cB;
        for (int t = 0; t < nt; t += 2) {
            const bool last = (t == nt - 2);
            const char* a1 = cA + (size_t)(t + 1) * kstep;
            const char* a2 = last ? nA : cA + (size_t)(t + 2) * kstep; const char* b2 = last ? nB : cB + (size_t)(t + 2) * kstep;
            const char* a3 = a2 + kstep; const char* b3 = b2 + kstep;
            if (last && has_next) S.a_ready(nxt);
            if constexpr (SP2) {
            PG8_LDB(B0, 0, 0); PG8_LDB(B1, 0, 1); PG8_SCHED; PG8_LDA(At, 0, 0); PG8_STAGE(PG8_SA(1, 1), a1 + hstep, voffA);
            PG8_WAIT_V(8); PG8_WAIT_L(0); PG8_BAR; PG8_MMA(0, 0, At, B0); PG8_MMA(0, 1, At, B1); PG8_BAR; PG8_SCHED;
            PG8_LDA(At, 0, 1); PG8_STAGE(PG8_SB(0, 0), b2, voffB); PG8_STAGE(PG8_SB(0, 1), b2, voffB1); PG8_STAGE(PG8_SA(0, 0), a2, voffA);
            PG8_WAIT_V(8); PG8_WAIT_L(0); PG8_BAR; PG8_MMA(1, 0, At, B0); PG8_MMA(1, 1, At, B1); PG8_BAR; PG8_SCHED;
            PG8_LDB(B0, 1, 0); PG8_LDB(B1, 1, 1); PG8_SCHED; PG8_LDA(At, 1, 0); PG8_STAGE(PG8_SA(0, 1), a2 + hstep, voffA);
            PG8_WAIT_V(8); PG8_WAIT_L(0); PG8_BAR; PG8_MMA(0, 0, At, B0); PG8_MMA(0, 1, At, B1); PG8_BAR; PG8_SCHED;
            PG8_LDA(At, 1, 1); PG8_STAGE(PG8_SB(1, 0), b3, voffB); PG8_STAGE(PG8_SB(1, 1), b3, voffB1); PG8_STAGE(PG8_SA(1, 0), a3, voffA);
            PG8_WAIT_V(8); PG8_WAIT_L(0); PG8_BAR; PG8_MMA(1, 0, At, B0); PG8_MMA(1, 1, At, B1); PG8_BAR; PG8_SCHED;
            } else {
            PG8_LDB(B0, 0, 0); PG8_SCHED; PG8_LDA(At, 0, 0); PG8_STAGE(PG8_SA(1, 1), a1 + hstep, voffA);
            PG8_WAIT_L(8); PG8_BAR; PG8_WAIT_L(0); PG8_MMA(0, 0, At, B0); PG8_BAR; PG8_SCHED;
            PG8_LDB(B1, 0, 1); PG8_STAGE(PG8_SB(0, 0), b2, voffB);
            PG8_BAR; PG8_WAIT_L(0); PG8_MMA(0, 1, At, B1); PG8_BAR;
            PG8_LDA(At, 0, 1); PG8_STAGE(PG8_SA(0, 0), a2, voffA);
            PG8_BAR; PG8_WAIT_L(0); PG8_MMA(1, 0, At, B0); PG8_BAR; PG8_SCHED;
            PG8_STAGE(PG8_SB(0, 1), b2, voffB1);
            PG8_WAIT_V(6); PG8_BAR; PG8_MMA(1, 1, At, B1); PG8_BAR;
            PG8_LDB(B0, 1, 0); PG8_SCHED; PG8_LDA(At, 1, 0); PG8_STAGE(PG8_SA(0, 1), a2 + hstep, voffA);
            PG8_WAIT_L(8); PG8_BAR; PG8_WAIT_L(0); PG8_MMA(0, 0, At, B0); PG8_BAR; PG8_SCHED;
            PG8_LDB(B1, 1, 1); PG8_STAGE(PG8_SB(1, 0), b3, voffB);
            PG8_BAR; PG8_WAIT_L(0); PG8_MMA(0, 1, At, B1); PG8_BAR;
            PG8_LDA(At, 1, 1); PG8_STAGE(PG8_SA(1, 0), a3, voffA);
            PG8_BAR; PG8_WAIT_L(0); PG8_MMA(1, 0, At, B0); PG8_BAR; PG8_SCHED;
            PG8_STAGE(PG8_SB(1, 1), b3, voffB1);
            PG8_WAIT_V(6); PG8_BAR; PG8_MMA(1, 1, At, B1); PG8_BAR;
            }
        }
        if constexpr (ALIGN_EPI) { if (wr == 0) PG8_BAR; }
        if constexpr (!Epi::AFTER_DRAIN) { E(acc, cur, wr, wc, fr, fq); S.done(cur); }
        if (!has_next) break;
#pragma unroll
        for (int a = 0; a < 2; ++a)
#pragma unroll
            for (int b = 0; b < 2; ++b)
#pragma unroll
                for (int m = 0; m < 4; ++m)
#pragma unroll
                    for (int n = 0; n < 2; ++n) acc[a][b][m][n] = (f32x4){0.f, 0.f, 0.f, 0.f};
        cur = nxt; cA = nA; cB = nB; ++ui;
        if constexpr (ALIGN_EPI) { if (wr == 1) PG8_BAR; }
    }
    PG8_WAIT_V(0);
    if constexpr (!ALIGN_EPI) { if (wr == 0) PG8_BAR; }
    PG8_BAR;
#undef PG8_SA
#undef PG8_SB
#undef PG8_STAGE
#undef PG8_LDA
#undef PG8_LDB
#undef PG8_MMA
#undef PG8_WAIT_V
#undef PG8_WAIT_L
#undef PG8_BAR
#undef PG8_SCHED
}
}

constexpr int NWAVES = 8, NTHR = NWAVES * 64;
#ifndef MK_N_LAUNCHES
#define MK_N_LAUNCHES 1
#endif
constexpr int N_LAUNCHES = MK_N_LAUNCHES;
constexpr int PER_PHASE = 12;
constexpr int CW_TMO = 0, CW_CODE = 1, CW_BAR = 4096;
constexpr int RING_OFF = 0, RING_BYTES = 131072, LDSCTL_OFF = RING_BYTES, MISC_OFF = LDSCTL_OFF + 320, LDS_BYTES = 147456;

typedef GAS unsigned gu32;
#define RLX_AGENT __ATOMIC_RELAXED, __HIP_MEMORY_SCOPE_AGENT
#define LDS_WAIT() asm volatile("s_waitcnt lgkmcnt(0)" ::: "memory")
#define VM_WAIT() asm volatile("s_waitcnt vmcnt(0)" ::: "memory")

#define XB_TMO      128
#define XB_XCNT(j)  (256  + 64 * (j))
#define XB_XSUB(j)  (1280 + 64 * (j))
#define XB_XGEN(j)  (2304 + 64 * (j))
#define XB_TOP      3328
#define XB_TOPGEN   3392
#define XCD_BAR_WORDS 3456
#define XB_SPIN_CAP (1u << 18)
__device__ __forceinline__ unsigned xb_ld(unsigned* p)              { return __hip_atomic_load(p, __ATOMIC_RELAXED, __HIP_MEMORY_SCOPE_AGENT); }
__device__ __forceinline__ unsigned xb_add(unsigned* p, unsigned v) { return __hip_atomic_fetch_add(p, v, __ATOMIC_RELAXED, __HIP_MEMORY_SCOPE_AGENT); }
__device__ __forceinline__ unsigned xb_xcc_id() { return (unsigned)__builtin_amdgcn_s_getreg((3 << 11) | 20) & 0xFu; }
#define XB_SPIN(cond, bar) do { unsigned _sp = 0; while (cond) { __builtin_amdgcn_s_sleep(1); \
    if ((++_sp & 255u) == 0u) { if (xb_ld(&(bar)[XB_TMO])) break; if (_sp > XB_SPIN_CAP) { atomicAdd(&(bar)[XB_TMO], 1u); break; } } } } while (0)
struct XcdBarrier { unsigned* bar; unsigned x; volatile LAS unsigned* st; };
__device__ __forceinline__ XcdBarrier xcd_barrier_post(unsigned* bar, volatile LAS unsigned* st) {
    XcdBarrier b; b.bar = bar; b.x = xb_xcc_id(); b.st = st;
    if (threadIdx.x == 0) (void)xb_add(&bar[XB_XCNT(b.x)], 1u);
    return b;
}
__device__ __forceinline__ void xcd_barrier_complete(unsigned* bar, unsigned x, unsigned& nloc, unsigned& nx) {
    const unsigned G = gridDim.x * gridDim.y * gridDim.z;
    unsigned sum, cnt, mine, sp = 0u;
    for (;;) {
        sum = 0u; cnt = 0u; mine = 0u;
#pragma unroll
        for (unsigned j = 0; j < 16; ++j) { const unsigned c = xb_ld(&bar[XB_XCNT(j)]); sum += c; cnt += (c > 0u) ? 1u : 0u; mine = (j == x) ? c : mine; }
        if (sum == G) break;
        __builtin_amdgcn_s_sleep(1);
        if ((++sp & 255u) == 0u) { if (xb_ld(&bar[XB_TMO])) break; if (sp > XB_SPIN_CAP) { atomicAdd(&bar[XB_TMO], 1u); break; } }
    }
    nloc = mine > 0u ? mine : 1u; nx = cnt > 0u ? cnt : 1u;
}
__device__ __forceinline__ void xcd_barrier(const XcdBarrier& b) {
    asm volatile("s_waitcnt vmcnt(0)" ::: "memory");
    __syncthreads();
    if (threadIdx.x == 0) {
        unsigned* bar = b.bar;
        __builtin_amdgcn_s_waitcnt(0);
        unsigned nloc = b.st[0], nx = b.st[1];
        if (nloc == 0u) { xcd_barrier_complete(bar, b.x, nloc, nx); b.st[0] = nloc; b.st[1] = nx; }
        const unsigned old = xb_add(&bar[XB_XSUB(b.x)], 1u);
        const unsigned gen = old / nloc;
        if (old + 1u == (gen + 1u) * nloc) {
            __builtin_amdgcn_fence(__ATOMIC_RELEASE, "agent");
            asm volatile("s_waitcnt vmcnt(0)" ::: "memory");
            const unsigned og = xb_add(&bar[XB_TOP], 1u);
            const unsigned tg = og / nx;
            if (og + 1u == (tg + 1u) * nx) xb_add(&bar[XB_TOPGEN], 1u);
            else XB_SPIN(xb_ld(&bar[XB_TOPGEN]) == tg, bar);
            __builtin_amdgcn_fence(__ATOMIC_ACQUIRE, "agent");
            xb_add(&bar[XB_XGEN(b.x)], 1u);
            asm volatile("s_waitcnt vmcnt(0)" ::: "memory");
        } else {
            XB_SPIN(xb_ld(&bar[XB_XGEN(b.x)]) == gen, bar);
            __builtin_amdgcn_fence(__ATOMIC_ACQUIRE, "agent");
            asm volatile("s_waitcnt vmcnt(0)" ::: "memory");
        }
    }
    __syncthreads();
}

struct Args { const float* in[28]; float* out; unsigned char* ws; int ph_lo, ph_hi, li, pad; };

__device__ __forceinline__ float wave_sum(float v) {
#pragma unroll
    for (int o = 1; o < 64; o <<= 1) v += __shfl_xor(v, o);
    return v;
}

__device__ __forceinline__ void p0_transpose_item(const float* W, int K, int N, bf16_t* WT, const float* g, LAS float* scr, int item, int lane) {
    const int nblk = N / 32, kb = item / nblk, nb = item % nblk, k0 = 64 * kb, n0 = 32 * nb;
#pragma unroll 8
    for (int i = 0; i < 32; ++i) { const int kk = 2 * i + (lane >> 5); const float gv = g ? g[k0 + kk] : 1.0f; scr[kk * 33 + (lane & 31)] = W[(size_t)(k0 + kk) * N + n0 + (lane & 31)] * gv; }
    LDS_WAIT(); asm volatile("" ::: "memory");
    const int c = lane & 7;
#pragma unroll
    for (int j = 0; j < 4; ++j) { const int n = (lane >> 3) + 8 * j; const LAS float* s = scr + (8 * c) * 33 + n;
        u32x4 o; o.x = cvtpk(s[0 * 33], s[1 * 33]); o.y = cvtpk(s[2 * 33], s[3 * 33]); o.z = cvtpk(s[4 * 33], s[5 * 33]); o.w = cvtpk(s[6 * 33], s[7 * 33]);
        *(GAS u32x4*)(WT + (size_t)(n0 + n) * K + k0 + 8 * c) = o; }
    LDS_WAIT(); asm volatile("" ::: "memory");
}

__device__ __forceinline__ void p0_prologue(const Args& a, LAS unsigned char* lds, int vcu, int G, int tid, int lane, int wave) {
    unsigned char* ws = a.ws;
    LAS float* scr = (LAS float*)(lds + RING_OFF + wave * 16384);
    const int gw = vcu * NWAVES + wave, NGW = G * NWAVES;
    constexpr int I_WIN = 16 * 56, I_WOUT = 16 * 32, I_W1 = 16 * 128, I_W2 = 64 * 32, I_WINO = 16 * 64, I_GATE = 2;
    constexpr int NITEMS = I_WIN + I_WOUT + 2 * I_W1 + 2 * I_W2 + I_WINO + I_WOUT + 16 * I_GATE;
    for (int it = gw; it < NITEMS; it += NGW) {
        int r = it;
        if (r < I_WIN) { p0_transpose_item(a.in[7], D, EIN, (bf16_t*)(ws + WS_WIN_E), a.in[6], scr, r, lane); continue; } r -= I_WIN;
        if (r < I_WOUT) { p0_transpose_item(a.in[18], D, D, (bf16_t*)(ws + WS_WOUT_E), nullptr, scr, r, lane); continue; } r -= I_WOUT;
        if (r < I_W1) { p0_transpose_item(a.in[26], D, FF, (bf16_t*)(ws + WS_W1A), a.in[25], scr, r, lane); continue; } r -= I_W1;
        if (r < I_W1) { p0_transpose_item(a.in[26] + (size_t)D * FF, D, FF, (bf16_t*)(ws + WS_W1B), a.in[25] + D, scr, r, lane); continue; } r -= I_W1;
        if (r < I_W2) { p0_transpose_item(a.in[27], FF, D, (bf16_t*)(ws + WS_W2A), nullptr, scr, r, lane); continue; } r -= I_W2;
        if (r < I_W2) { p0_transpose_item(a.in[27] + (size_t)D * FF, FF, D, (bf16_t*)(ws + WS_W2B), nullptr, scr, r, lane); continue; } r -= I_W2;
        if (r < I_WINO) { p0_transpose_item(a.in[20], D, 2 * D, (bf16_t*)(ws + WS_WIN_O), a.in[19], scr, r, lane); continue; } r -= I_WINO;
        if (r < I_WOUT) { p0_transpose_item(a.in[24], D, D, (bf16_t*)(ws + WS_WOUT_O), nullptr, scr, r, lane); continue; } r -= I_WOUT;
        { const int blk = r >> 1, sub = r & 1;
          const float* src = (blk < 8 ? a.in[13] : a.in[15]) + (size_t)(blk & 7) * 4096;
          p0_transpose_item(src, 64, 64, (bf16_t*)(ws + WS_GATE) + (size_t)blk * 4096, nullptr, scr, sub, lane); }
    }
    for (int m = gw; m < M; m += NGW) {
        const float* xrow = (m < MP) ? a.in[0] + (size_t)m * D : a.in[1] + (size_t)(m - MP) * D;
        const GAS f32x4* xr = (const GAS f32x4*)xrow + lane;
        f32x4 v[4]; float s = 0.f;
#pragma unroll
        for (int j = 0; j < 4; ++j) { v[j] = xr[64 * j]; s += (v[j][0] * v[j][0] + v[j][1] * v[j][1]) + (v[j][2] * v[j][2] + v[j][3] * v[j][3]); }
        s = wave_sum(s);
        if (lane == 0) ((float*)(ws + WS_RS0))[m] = __builtin_amdgcn_rsqf(s * (1.0f / D) + EPS);
        GAS u32x2* o8 = (GAS u32x2*)((bf16_t*)(ws + WS_XB) + (size_t)m * D) + lane;
#pragma unroll
        for (int j = 0; j < 4; ++j) o8[64 * j] = (u32x2){cvtpk(v[j][0], v[j][1]), cvtpk(v[j][2], v[j][3])};
    }
    const int gt = vcu * NTHR + tid, NGT = G * NTHR;
    for (int i = gt; i < SEQ * 32; i += NGT) {
        const int pos = i >> 5, k = i & 31;
        const float inv = (float)exp2(-(double)k * (13.287712379549449 / 32.0));
        const float ang = (float)pos * inv;
        double sn, cn; sincos((double)ang, &sn, &cn);
        ((f32x2*)(ws + WS_ROPE))[i] = (f32x2){(float)cn, (float)sn};
    }
    for (int i = gt; i < DL; i += NGT) { const double l = (double)a.in[17][i]; ((float*)(ws + WS_SP8))[i] = (float)(8.0 * log1p(exp(-l))); }
    for (int i = gt; i < 8 * 128 * 128; i += NGT) { const int t = (i >> 7) & 127, s = i & 127; const float w = (s <= t) ? a.in[22][i] : 0.f; ((bf16_t*)(ws + WS_SPW))[i] = (bf16_t)(cvtpk(w, 0.f) & 0xffffu); }
    for (int i = gt; i < DB * 112 * 32; i += NGT) {
        const int b = i / 3584, q = i % 3584;
        const f32x4 kv = ((const f32x4*)a.in[2])[(size_t)b * 4096 + 512 + q], vv = ((const f32x4*)a.in[3])[(size_t)b * 4096 + 512 + q];
        ((f32x4*)(a.out + pg8::EpiIn::O_KS))[(size_t)b * 4096 + q] = kv; ((f32x4*)(a.out + pg8::EpiIn::O_VS))[(size_t)b * 4096 + q] = vv;
    }
}

constexpr int AT_KS = 0, AT_VT = 24576, AT_VTS = 392;
__device__ __forceinline__ int crow(int r, int hi) { return (r & 3) + 8 * (r >> 2) + 4 * hi; }
template <bool SAMPLE>
__device__ __forceinline__ void attn_unit(const Args& a, LAS unsigned char* lds, int b, int c, int kh, int tid, int lane, int wave) {
    constexpr int NKT = SAMPLE ? 5 : 6, NROW = NKT * 32;
    const bf16_t* H1 = (const bf16_t*)(a.ws + WS_H1);
    for (int idx = tid; idx < NROW * 8; idx += NTHR) {
        const int row = idx >> 3, ch = idx & 7;
        u32x4 kq = {0u, 0u, 0u, 0u}, vq = {0u, 0u, 0u, 0u};
        if (!SAMPLE) {
            const int t = (c - 2) * 64 + row;
            if (t >= 0) { const bf16_t* p = H1 + (size_t)(b * SEQ + t) * EIN + 64 * kh + 8 * ch; kq = *(const u32x4*)(p + C_K); vq = *(const u32x4*)(p + C_V); }
        } else {
            if (row < 128) { const size_t o = ((size_t)(b * 128 + row) * 2 + kh) * 64 + 8 * ch;
                const f32x4 k0 = *(const f32x4*)(a.in[2] + o), k1 = *(const f32x4*)(a.in[2] + o + 4), v0 = *(const f32x4*)(a.in[3] + o), v1 = *(const f32x4*)(a.in[3] + o + 4);
                kq = (u32x4){cvtpk(k0[0], k0[1]), cvtpk(k0[2], k0[3]), cvtpk(k1[0], k1[1]), cvtpk(k1[2], k1[3])};
                vq = (u32x4){cvtpk(v0[0], v0[1]), cvtpk(v0[2], v0[3]), cvtpk(v1[0], v1[1]), cvtpk(v1[2], v1[3])}; }
            else if (row < 144) { const bf16_t* p = H1 + (size_t)(MP + b * DS + (row - 128)) * EIN + 64 * kh + 8 * ch; kq = *(const u32x4*)(p + C_K); vq = *(const u32x4*)(p + C_V); }
        }
        *(LAS u32x4*)(lds + AT_KS + row * 128 + ((ch ^ (row & 7)) << 4)) = kq;
        LAS bf16_t* vt = (LAS bf16_t*)(lds + AT_VT) + row;
        const unsigned vw[4] = {vq.x, vq.y, vq.z, vq.w};
#pragma unroll
        for (int i = 0; i < 4; ++i) { vt[(8 * ch + 2 * i) * (AT_VTS / 2)] = (bf16_t)(vw[i] & 0xffffu); vt[(8 * ch + 2 * i + 1) * (AT_VTS / 2)] = (bf16_t)(vw[i] >> 16); }
    }
    __syncthreads();
    if (!SAMPLE || wave < 2) {
        const int ql = lane & 31, hi = lane >> 5;
        int qrow, head;
        if (!SAMPLE) { head = 4 * kh + (wave >> 1); qrow = b * SEQ + c * 64 + 32 * (wave & 1) + ql; }
        else { const int idx = 32 * wave + ql; head = 4 * kh + (idx >> 4); qrow = MP + b * DS + (idx & 15); }
        bf16x8 qf[4];
#pragma unroll
        for (int s = 0; s < 4; ++s) qf[s] = *(const bf16x8*)(H1 + (size_t)qrow * EIN + head * 64 + 16 * s + 8 * hi);
        const float sinkl = a.in[10][head] * LOG2E;
        f32x16 S[NKT];
        const int kt0 = SAMPLE ? 0 : (c >= 2 ? 0 : (2 - c) * 2);
#pragma unroll
        for (int kt = 0; kt < NKT; ++kt) {
            f32x16 acc = {};
#pragma unroll
            for (int s = 0; s < 4; ++s) {
                const bf16x8 kf = *(const LAS bf16x8*)(lds + AT_KS + (32 * kt + ql) * 128 + (((2 * s + hi) ^ (ql & 7)) << 4));
                acc = __builtin_amdgcn_mfma_f32_32x32x16_bf16(kf, qf[s], acc, 0, 0, 0);
            }
            if (!SAMPLE) { if (kt < kt0) {
#pragma unroll
                for (int r = 0; r < 16; ++r) acc[r] = -1e30f; } }
            else if (kt == NKT - 1) {
#pragma unroll
                for (int r = 8; r < 16; ++r) acc[r] = -1e30f; }
            S[kt] = acc;
        }
        float mx = sinkl;
#pragma unroll
        for (int kt = 0; kt < NKT; ++kt)
#pragma unroll
            for (int r = 0; r < 16; ++r) mx = fmaxf(mx, S[kt][r]);
        mx = fmaxf(mx, __shfl_xor(mx, 32));
        float ls = 0.f;
#pragma unroll
        for (int kt = 0; kt < NKT; ++kt)
#pragma unroll
            for (int r = 0; r < 16; ++r) { const float p = __builtin_amdgcn_exp2f(S[kt][r] - mx); S[kt][r] = p; ls += p; }
        ls += __shfl_xor(ls, 32);
        ls += __builtin_amdgcn_exp2f(sinkl - mx);
        const float inv = 1.0f / ls;
        f32x16 o[2] = {};
#pragma unroll
        for (int kt = 0; kt < NKT; ++kt)
#pragma unroll
            for (int s = 0; s < 2; ++s) {
                u32x4 pw; pw.x = cvtpk(S[kt][8 * s], S[kt][8 * s + 1]); pw.y = cvtpk(S[kt][8 * s + 2], S[kt][8 * s + 3]); pw.z = cvtpk(S[kt][8 * s + 4], S[kt][8 * s + 5]); pw.w = cvtpk(S[kt][8 * s + 6], S[kt][8 * s + 7]);
                const bf16x8 pf = __builtin_bit_cast(bf16x8, pw);
#pragma unroll
                for (int dt = 0; dt < 2; ++dt) {
                    const LAS unsigned char* vp = lds + AT_VT + (32 * dt + ql) * AT_VTS + (32 * kt + 16 * s + 4 * hi) * 2;
                    const u32x2 v0 = *(const LAS u32x2*)vp, v1 = *(const LAS u32x2*)(vp + 16);
                    const u32x4 vw = {v0.x, v0.y, v1.x, v1.y};
                    o[dt] = __builtin_amdgcn_mfma_f32_32x32x16_bf16(__builtin_bit_cast(bf16x8, vw), pf, o[dt], 0, 0, 0);
                }
            }
        bf16_t* orow = (bf16_t*)(a.ws + WS_AO) + (size_t)qrow * D + head * 64 + 4 * hi;
#pragma unroll
        for (int dt = 0; dt < 2; ++dt)
#pragma unroll
            for (int gq = 0; gq < 4; ++gq) {
                const u32x2 w = {cvtpk(o[dt][4 * gq] * inv, o[dt][4 * gq + 1] * inv), cvtpk(o[dt][4 * gq + 2] * inv, o[dt][4 * gq + 3] * inv)};
                *(u32x2*)(orow + 32 * dt + 8 * gq) = w;
            }
    }
    __syncthreads();
}

constexpr int LR_XC = 0;
constexpr int LR_XF = 16384;
constexpr int LR_A = 49152;
constexpr int LR_B = 81920;
constexpr int LR_SEG = 114688;
constexpr int LR_CAR = 118784;
template <bool APPLY, bool SAMPLE>
__device__ __forceinline__ void lru_unit(const Args& a, LAS unsigned char* lds, int b, int blk, int cg, int tid, int lane, int wave) {
    const bf16_t* H1 = (const bf16_t*)(a.ws + WS_H1);
    const int ch0 = 128 * cg;
    const size_t row0 = SAMPLE ? (size_t)(MP + b * DS) : (size_t)b * SEQ + (size_t)blk * 256;
    LAS float* XF = (LAS float*)(lds + LR_XF); LAS float* LA = (LAS float*)(lds + LR_A); LAS float* LB = (LAS float*)(lds + LR_B);
    LAS f32x2* SEG = (LAS f32x2*)(lds + LR_SEG); LAS float* CAR = (LAS float*)(lds + LR_CAR);
    const int ct = wave & 3, tt = wave >> 2, ql = lane & 31, hi = lane >> 5;
    const int nblk = 2 * cg + (ct >> 1), dofs = 32 * (ct & 1);
    bf16x8 wf[2][4];
#pragma unroll
    for (int gte = 0; gte < 2; ++gte)
#pragma unroll
        for (int s = 0; s < 4; ++s) wf[gte][s] = *(const bf16x8*)((const bf16_t*)(a.ws + WS_GATE) + (size_t)(gte * 8 + nblk) * 4096 + (dofs + ql) * 64 + 16 * s + 8 * hi);
    const int chw = ch0 + 32 * ct + ql;
    const float ba = a.in[14][chw], bx = a.in[16][chw], sp8 = ((const float*)(a.ws + WS_SP8))[chw];
    const int sch = tid & 127, seg = tid >> 7;
    float Aun = 1.f, Hun = 0.f;
    if (APPLY) {
        if (tid < 128) {
            float h;
            if (SAMPLE) h = a.in[4][b * DL + ch0 + tid];
            else { h = 0.f; const f32x2* cp = (const f32x2*)(a.ws + WS_CARRY) + (size_t)b * 32 * DL + ch0 + tid;
#pragma unroll 8
                for (int j = 0; j < 32; ++j) { const int jj = j < blk ? j : 0; const f32x2 ah = cp[(size_t)jj * DL]; const float A_ = j < blk ? ah.x : 1.f, H_ = j < blk ? ah.y : 0.f; h = A_ * h + H_; } }
            CAR[tid] = h;
        }
    }
    constexpr int NSUB = SAMPLE ? 1 : 4;
    for (int sc = 0; sc < NSUB; ++sc) {
        const int t0 = 64 * sc;
        for (int idx = tid; idx < 64 * 16; idx += NTHR) {
            const int tok = idx >> 4, c8 = idx & 15, ch = ch0 + 8 * c8;
            float xc[8];
            { const f32x4 b0 = *(const f32x4*)(a.in[12] + ch), b1 = *(const f32x4*)(a.in[12] + ch + 4);
              xc[0] = b0[0]; xc[1] = b0[1]; xc[2] = b0[2]; xc[3] = b0[3]; xc[4] = b1[0]; xc[5] = b1[1]; xc[6] = b1[2]; xc[7] = b1[3]; }
            const bool live = !SAMPLE || tok < DS;
#pragma unroll
            for (int i = 0; i < 4; ++i) {
                const int tl = t0 + tok - 3 + i;
                float xv[8];
                bool have = live;
                if (SAMPLE) {
                    if (tl < 0) { const float* p = a.in[5] + (size_t)(b * 3 + (3 + tl)) * DL + ch; const f32x4 p0 = *(const f32x4*)p, p1 = *(const f32x4*)(p + 4);
                        xv[0] = p0[0]; xv[1] = p0[1]; xv[2] = p0[2]; xv[3] = p0[3]; xv[4] = p1[0]; xv[5] = p1[1]; xv[6] = p1[2]; xv[7] = p1[3]; }
                    else { const u32x4 w = *(const u32x4*)(H1 + (row0 + (live ? tl : 0)) * EIN + C_XR + ch);
                        xv[0] = bflo(w.x); xv[1] = bfhi(w.x); xv[2] = bflo(w.y); xv[3] = bfhi(w.y); xv[4] = bflo(w.z); xv[5] = bfhi(w.z); xv[6] = bflo(w.w); xv[7] = bfhi(w.w); }
                } else {
                    const long tg = (long)blk * 256 + tl;
                    have = tg >= 0;
                    const u32x4 w = *(const u32x4*)(H1 + ((size_t)b * SEQ + (size_t)(have ? tg : 0)) * EIN + C_XR + ch);
                    xv[0] = bflo(w.x); xv[1] = bfhi(w.x); xv[2] = bflo(w.y); xv[3] = bfhi(w.y); xv[4] = bflo(w.z); xv[5] = bfhi(w.z); xv[6] = bflo(w.w); xv[7] = bfhi(w.w);
                }
                const f32x4 w0 = *(const f32x4*)(a.in[11] + i * DL + ch), w1 = *(const f32x4*)(a.in[11] + i * DL + ch + 4);
                const float wv[8] = {w0[0], w0[1], w0[2], w0[3], w1[0], w1[1], w1[2], w1[3]};
#pragma unroll
                for (int e = 0; e < 8; ++e) xc[e] += have ? xv[e] * wv[e] : 0.f;
            }
            if (!live) {
#pragma unroll
                for (int e = 0; e < 8; ++e) xc[e] = 0.f; }
            *(LAS f32x4*)(XF + tok * 128 + 8 * c8) = (f32x4){xc[0], xc[1], xc[2], xc[3]}; *(LAS f32x4*)(XF + tok * 128 + 8 * c8 + 4) = (f32x4){xc[4], xc[5], xc[6], xc[7]};
            *(LAS u32x4*)(lds + LR_XC + tok * 256 + ((c8 ^ (tok & 15)) << 4)) = (u32x4){cvtpk(xc[0], xc[1]), cvtpk(xc[2], xc[3]), cvtpk(xc[4], xc[5]), cvtpk(xc[6], xc[7])};
        }
        __syncthreads();
        {
            f32x16 ga = {}, gx = {};
#pragma unroll
            for (int s = 0; s < 4; ++s) {
                const int tok = 32 * tt + ql, c8 = 8 * (ct >> 1) + 2 * s + hi;
                const bf16x8 xa = *(const LAS bf16x8*)(lds + LR_XC + tok * 256 + ((c8 ^ (tok & 15)) << 4));
                ga = __builtin_amdgcn_mfma_f32_32x32x16_bf16(xa, wf[0][s], ga, 0, 0, 0);
                gx = __builtin_amdgcn_mfma_f32_32x32x16_bf16(xa, wf[1][s], gx, 0, 0, 0);
            }
#pragma unroll
            for (int r = 0; r < 16; ++r) {
                const int tok = 32 * tt + crow(r, hi), cl = 32 * ct + ql;
                const float rg = sigmoid_f(ga[r] + ba), ig = sigmoid_f(gx[r] + bx);
                const float la = -rg * sp8;
                const float av = __expf(la);
                const float bt = sqrtf(-expm1f(2.0f * la)) * (ig * XF[tok * 128 + cl]);
                LA[tok * 128 + cl] = av; LB[tok * 128 + cl] = bt;
            }
        }
        __syncthreads();
        if (!SAMPLE || seg == 0) {
            float P = 1.f, Hh = 0.f;
#pragma unroll
            for (int i = 0; i < 16; ++i) { const float av = LA[(16 * seg + i) * 128 + sch], bv = LB[(16 * seg + i) * 128 + sch]; Hh = av * Hh + bv; P *= av; }
            SEG[seg * 128 + sch] = (f32x2){P, Hh};
        }
        __syncthreads();
        if (!APPLY) {
            if (seg == 0) {
                float Ps = 1.f, Hs = 0.f;
#pragma unroll
                for (int s = 0; s < 4; ++s) { const f32x2 ph = SEG[s * 128 + sch]; Hs = ph.x * Hs + ph.y; Ps *= ph.x; }
                Hun = Ps * Hun + Hs; Aun *= Ps;
            }
        } else {
            if (!SAMPLE || seg == 0) {
                float h = CAR[sch];
#pragma unroll
                for (int s = 0; s < 3; ++s) if (s < seg) { const f32x2 ph = SEG[s * 128 + sch]; h = ph.x * h + ph.y; }
                const size_t rbase = row0 + (size_t)(SAMPLE ? 0 : t0) + 16 * seg;
                const bf16_t* gp = H1 + rbase * EIN + C_GR + ch0 + sch;
                bf16_t* op = (bf16_t*)(a.ws + WS_AO) + rbase * D + 512 + ch0 + sch;
#pragma unroll
                for (int i = 0; i < 16; ++i) {
                    const float av = LA[(16 * seg + i) * 128 + sch], bv = LB[(16 * seg + i) * 128 + sch];
                    h = av * h + bv;
                    const float gg = __uint_as_float((unsigned)gp[(size_t)i * EIN] << 16);
                    op[(size_t)i * D] = (bf16_t)(cvtpk(h * gg, 0.f) & 0xffffu);
                }
                if (SAMPLE) a.out[pg8::EpiIn::O_HS + (size_t)b * DL + ch0 + sch] = h;
                else if (seg == 3) { Hun = h; }
            }
            __syncthreads();
            if (!SAMPLE && seg == 3) CAR[sch] = Hun;
        }
        __syncthreads();
    }
    if (!APPLY) { if (seg == 0) ((f32x2*)(a.ws + WS_CARRY))[((size_t)b * 32 + blk) * DL + ch0 + sch] = (f32x2){Aun, Hun}; }
    else if (!SAMPLE && blk == 31 && seg == 3) a.out[pg8::EpiIn::O_HP + (size_t)b * DL + ch0 + sch] = Hun;
}

constexpr int GT_W = 0;
constexpr int GT_V = 32768;
constexpr int GT_ST = 65536;
constexpr int GT_VF = 66560;
__device__ __forceinline__ f32x2 ln_stats(const f32x2* lnp, int r) {
    const f32x4* p = (const f32x4*)(lnp + (size_t)r * 16); float s1 = 0.f, s2 = 0.f;
#pragma unroll
    for (int i = 0; i < 8; ++i) { const f32x4 v = p[i]; s1 += v[0] + v[2]; s2 += v[1] + v[3]; }
    const float mean = s1 * (1.0f / D), var = s2 * (1.0f / D) - mean * mean;
    return (f32x2){mean, __builtin_amdgcn_rsqf(fmaxf(var, 0.f) + EPS)};
}
__device__ __forceinline__ void gate_load_w(const Args& a, LAS unsigned char* lds, int g, int tid) {
    const bf16_t* W = (const bf16_t*)(a.ws + WS_SPW) + (size_t)g * 16384;
    for (int idx = tid; idx < 128 * 16; idx += NTHR) { const int t = idx >> 4, ch = idx & 15; *(LAS u32x4*)(lds + GT_W + t * 256 + ((ch ^ (t & 15)) << 4)) = *(const u32x4*)(W + t * 128 + 8 * ch); }
}
__device__ __forceinline__ void gate_unit(const Args& a, LAS unsigned char* lds, int j, int g, int tid, int lane, int wave) {
    const bf16_t* Z = (const bf16_t*)(a.ws + WS_Z);
    const f32x2* lnp = (const f32x2*)(a.ws + WS_LNP);
    LAS f32x2* ST = (LAS f32x2*)(lds + GT_ST);
    const size_t row0 = (size_t)j * 128;
    if (tid < 128) ST[tid] = ln_stats(lnp, (int)row0 + tid);
    __syncthreads();
    for (int idx = tid; idx < 128 * 16; idx += NTHR) {
        const int s = idx >> 4, cw = idx & 15;
        const u32x4 w = *(const u32x4*)(Z + (row0 + s) * 2048 + 1024 + g * 128 + 8 * cw);
        const f32x4 g0 = *(const f32x4*)(a.in[21] + g * 128 + 8 * cw), g1 = *(const f32x4*)(a.in[21] + g * 128 + 8 * cw + 4);
        const f32x2 st = ST[s];
        const float v[8] = {(bflo(w.x) - st.x) * st.y * g0[0], (bfhi(w.x) - st.x) * st.y * g0[1], (bflo(w.y) - st.x) * st.y * g0[2], (bfhi(w.y) - st.x) * st.y * g0[3],
                            (bflo(w.z) - st.x) * st.y * g1[0], (bfhi(w.z) - st.x) * st.y * g1[1], (bflo(w.w) - st.x) * st.y * g1[2], (bfhi(w.w) - st.x) * st.y * g1[3]};
#pragma unroll
        for (int i = 0; i < 8; ++i) { const int wv = 8 * cw + i; *(LAS bf16_t*)(lds + GT_V + wv * 256 + (((s >> 3) ^ (wv & 15)) << 4) + (s & 7) * 2) = (bf16_t)(cvtpk(v[i], 0.f) & 0xffffu); }
    }
    __syncthreads();
    const int wi = wave & 3, ql = lane & 31, hi = lane >> 5;
    const bf16_t* U = Z;
    bf16_t* O = (bf16_t*)(a.ws + WS_AO2);
#pragma unroll
    for (int q = 0; q < 2; ++q) {
        const int tj = (wave < 4) ? (q == 0 ? 0 : 3) : (q == 0 ? 1 : 2);
        f32x16 acc = {};
        for (int st = 0; st < 2 * (tj + 1); ++st) {
            const int wv = 32 * wi + ql, t = 32 * tj + ql, chk = 2 * st + hi;
            const bf16x8 af = *(const LAS bf16x8*)(lds + GT_V + wv * 256 + ((chk ^ (wv & 15)) << 4));
            const bf16x8 bf = *(const LAS bf16x8*)(lds + GT_W + t * 256 + ((chk ^ (t & 15)) << 4));
            acc = __builtin_amdgcn_mfma_f32_32x32x16_bf16(af, bf, acc, 0, 0, 0);
        }
        const int t = 32 * tj + ql; const float bs = a.in[23][g * 128 + t];
        const size_t r = row0 + t;
#pragma unroll
        for (int gq = 0; gq < 4; ++gq) {
            const int wv = 32 * wi + 8 * gq + 4 * hi;
            const u32x2 uw = *(const u32x2*)(U + r * 2048 + g * 128 + wv);
            const u32x2 ow = {cvtpk(bflo(uw.x) * (acc[4 * gq] + bs), bfhi(uw.x) * (acc[4 * gq + 1] + bs)), cvtpk(bflo(uw.y) * (acc[4 * gq + 2] + bs), bfhi(uw.y) * (acc[4 * gq + 3] + bs))};
            *(u32x2*)(O + r * D + g * 128 + wv) = ow;
        }
    }
    __syncthreads();
}
__device__ __forceinline__ void gate_unit_sample(const Args& a, LAS unsigned char* lds, int b, int g, int tid) {
    const bf16_t* Z = (const bf16_t*)(a.ws + WS_Z);
    const f32x2* lnp = (const f32x2*)(a.ws + WS_LNP);
    LAS float* VF = (LAS float*)(lds + GT_VF);
    const int t = tid >> 5, c4 = (tid & 31) * 4; const size_t r = (size_t)MP + b * DS + t;
    {
        const f32x2 st = ln_stats(lnp, (int)r);
        const u32x2 w = *(const u32x2*)(Z + r * 2048 + 1024 + g * 128 + c4);
        const f32x4 gv = *(const f32x4*)(a.in[21] + g * 128 + c4);
        const f32x4 v = {(bflo(w.x) - st.x) * st.y * gv[0], (bfhi(w.x) - st.x) * st.y * gv[1], (bflo(w.y) - st.x) * st.y * gv[2], (bfhi(w.y) - st.x) * st.y * gv[3]};
        *(LAS f32x4*)(VF + t * 128 + c4) = v;
        *(f32x4*)(a.out + pg8::EpiIn::O_GV + ((size_t)b * DS + t) * D + g * 128 + c4) = v;
    }
    __syncthreads();
    {
        const float bs = a.in[23][g * 128 + t];
        f32x4 sv = {bs, bs, bs, bs};
        const float* wrow = a.in[22] + ((size_t)g * 128 + t) * 128;
        for (int s = 0; s <= t; ++s) { const float w = wrow[s]; sv += w * *(const LAS f32x4*)(VF + s * 128 + c4); }
        const u32x2 uw = *(const u32x2*)(Z + r * 2048 + g * 128 + c4);
        const u32x2 ow = {cvtpk(bflo(uw.x) * sv[0], bfhi(uw.x) * sv[1]), cvtpk(bflo(uw.y) * sv[2], bfhi(uw.y) * sv[3])};
        *(u32x2*)((bf16_t*)(a.ws + WS_AO2) + r * D + g * 128 + c4) = ow;
    }
    __syncthreads();
}

__global__ void __launch_bounds__(NTHR, 2) mk_fwd(Args args) {
    extern __shared__ __attribute__((aligned(16))) unsigned char lds_raw[];
    LAS unsigned char* lds = (LAS unsigned char*)lds_raw;
    volatile LAS unsigned* MISC = (volatile LAS unsigned*)(lds + MISC_OFF);
    const int tid = threadIdx.x, lane = tid & 63, wave = __builtin_amdgcn_readfirstlane(tid >> 6);
    const int G = gridDim.x; const int bx = blockIdx.x; const int vcu = (G % 8 == 0) ? (bx % 8) * (G / 8) + bx / 8 : bx;
    gu32* ctl = (gu32*)(args.ws + WS_CTL);
    for (int u = tid; u < (LDS_BYTES - LDSCTL_OFF) / 4; u += NTHR) ((LAS unsigned*)(lds + LDSCTL_OFF))[u] = 0u;
    __syncthreads();
    XcdBarrier bar; bar.bar = (unsigned*)(ctl + CW_BAR) + args.li * XCD_BAR_WORDS; bar.x = 0; bar.st = nullptr;
    if (N_LAUNCHES != PER_PHASE) bar = xcd_barrier_post((unsigned*)(ctl + CW_BAR) + args.li * XCD_BAR_WORDS, MISC + 8);
#define GRID_BAR() do { if (N_LAUNCHES != PER_PHASE) xcd_barrier(bar); } while (0)
    const int lo = args.ph_lo, hi_ = args.ph_hi;
#define IN(k) (lo <= (k) && (k) < hi_)
#define BOTH(k) (IN(k) && IN((k) + 1))
    unsigned char* ws = args.ws;
    bf16_t* YA = (bf16_t*)(ws + WS_YA); bf16_t* YB = (bf16_t*)(ws + WS_YB); bf16_t* HID = (bf16_t*)(ws + WS_BIG);
    float* SSQ = (float*)(ws + WS_SSQ);

    if (IN(0)) { p0_prologue(args, lds, vcu, G, tid, lane, wave); if (BOTH(0)) GRID_BAR(); }

    if (IN(1)) {
        pg8::Gemm g{(const bf16_t*)(ws + WS_XB), (const bf16_t*)(ws + WS_WIN_E), M, EIN, D}; pg8::StaticOrder S; S.init(M, EIN, G, bx);
        pg8::EpiIn E{(bf16_t*)(ws + WS_H1), (const float*)(ws + WS_RS0), (const f32x4*)(ws + WS_ROPE), args.in[8], args.in[9], args.out};
        pg8::gemm_phase<pg8::EpiIn, pg8::StaticOrder, true, true>(lds + RING_OFF, g, S, E);
        if (BOTH(1)) GRID_BAR();
    }
    if (IN(2)) {
        for (int u = vcu; u < 256; u += G) lru_unit<false, false>(args, lds, u >> 7, (u >> 2) & 31, u & 3, tid, lane, wave);
        __syncthreads();
        for (int u = vcu; u < 512; u += G) attn_unit<false>(args, lds, u >> 8, (u >> 1) & 127, u & 1, tid, lane, wave);
        for (int u = vcu; u < 64; u += G) attn_unit<true>(args, lds, u >> 1, 0, u & 1, tid, lane, wave);
        for (int u = vcu - 64; u >= 0 && u < 128; u += G) lru_unit<true, true>(args, lds, u >> 2, 0, u & 3, tid, lane, wave);
        if (BOTH(2)) GRID_BAR();
    }
    if (IN(3)) {
        for (int u = vcu; u < 256; u += G) lru_unit<true, false>(args, lds, u >> 7, (u >> 2) & 31, u & 3, tid, lane, wave);
        if (BOTH(3)) GRID_BAR();
    }
    if (IN(4)) {
        pg8::Gemm g{(const bf16_t*)(ws + WS_AO), (const bf16_t*)(ws + WS_WOUT_E), M, D, D}; pg8::StaticOrder S; S.init(M, D, G, bx);
        pg8::EpiRes<true> E{args.in[0], args.in[1], nullptr, YA, SSQ};
        pg8::gemm_phase<pg8::EpiRes<true>, pg8::StaticOrder, true, true>(lds + RING_OFF, g, S, E);
        if (BOTH(4)) GRID_BAR();
    }
    if (IN(5)) {
        pg8::Gemm g{YA, (const bf16_t*)(ws + WS_W1A), M, FF, D}; pg8::StaticOrder S; S.init(M, FF, G, bx);
        pg8::EpiAct<0> E{SSQ, HID, FF, nullptr};
        pg8::gemm_phase<pg8::EpiAct<0>, pg8::StaticOrder, true, true>(lds + RING_OFF, g, S, E);
        if (BOTH(5)) GRID_BAR();
    }
    if (IN(6)) {
        pg8::Gemm g{HID, (const bf16_t*)(ws + WS_W2A), M, D, FF}; pg8::StaticOrder S; S.init(M, D, G, bx);
        pg8::EpiRes<false> E{nullptr, nullptr, YA, YB, SSQ};
        pg8::gemm_phase<pg8::EpiRes<false>, pg8::StaticOrder, true, true>(lds + RING_OFF, g, S, E);
        if (BOTH(6)) GRID_BAR();
    }
    if (IN(7)) {
        pg8::Gemm g{YB, (const bf16_t*)(ws + WS_WIN_O), M, 2 * D, D}; pg8::StaticOrder S; S.init(M, 2 * D, G, bx);
        pg8::EpiAct<1> E{SSQ, (bf16_t*)(ws + WS_Z), 2 * D, (f32x2*)(ws + WS_LNP)};
        pg8::gemm_phase<pg8::EpiAct<1>, pg8::StaticOrder, true, true>(lds + RING_OFF, g, S, E);
        if (BOTH(7)) GRID_BAR();
    }
    if (IN(8)) {
        const int g = vcu & 7;
        gate_load_w(args, lds, g, tid);
        __syncthreads();
        for (int j = vcu >> 3; j < 128; j += G / 8) gate_unit(args, lds, j, g, tid, lane, wave);
        for (int u = vcu; u < 256; u += G) gate_unit_sample(args, lds, u >> 3, u & 7, tid);
        if (BOTH(8)) GRID_BAR();
    }
    if (IN(9)) {
        pg8::Gemm g{(const bf16_t*)(ws + WS_AO2), (const bf16_t*)(ws + WS_WOUT_O), M, D, D}; pg8::StaticOrder S; S.init(M, D, G, bx);
        pg8::EpiRes<false> E{nullptr, nullptr, YB, YA, SSQ};
        pg8::gemm_phase<pg8::EpiRes<false>, pg8::StaticOrder, true, true>(lds + RING_OFF, g, S, E);
        if (BOTH(9)) GRID_BAR();
    }
    if (IN(10)) {
        pg8::Gemm g{YA, (const bf16_t*)(ws + WS_W1B), M, FF, D}; pg8::StaticOrder S; S.init(M, FF, G, bx);
        pg8::EpiAct<0> E{SSQ, HID, FF, nullptr};
        pg8::gemm_phase<pg8::EpiAct<0>, pg8::StaticOrder, true, true>(lds + RING_OFF, g, S, E);
        if (BOTH(10)) GRID_BAR();
    }
    if (IN(11)) {
        pg8::Gemm g{HID, (const bf16_t*)(ws + WS_W2B), M, D, FF}; pg8::StaticOrder S; S.init(M, D, G, bx);
        pg8::EpiOut E{YA, args.out};
        pg8::gemm_phase<pg8::EpiOut, pg8::StaticOrder, true, true>(lds + RING_OFF, g, S, E);
    }
#undef IN
#undef BOTH
#undef GRID_BAR
}

extern "C" void kernel_launch(void* const* d_in, const int* in_sizes, int n_in, void* d_out, int out_size, void* d_ws, size_t ws_size, hipStream_t stream) {
    static int grid = 0;
    if (grid == 0) {
        if (n_in != 28 || ws_size < WS_END) { fprintf(stderr, "kernel_launch: expected 28 inputs and >= %zu bytes of workspace; got %d, %zu\n", (size_t)WS_END, n_in, ws_size); grid = -1; return; }
        int dev = 0, cus = 0, per_cu = 0;
        if (hipGetDevice(&dev) != hipSuccess || hipDeviceGetAttribute(&cus, hipDeviceAttributeMultiprocessorCount, dev) != hipSuccess) { grid = -1; return; }
        if (hipFuncSetAttribute((const void*)mk_fwd, hipFuncAttributeMaxDynamicSharedMemorySize, LDS_BYTES) != hipSuccess) { fprintf(stderr, "kernel_launch: hipFuncSetAttribute failed\n"); grid = -1; return; }
        if (hipOccupancyMaxActiveBlocksPerMultiprocessor(&per_cu, (const void*)mk_fwd, NTHR, LDS_BYTES) != hipSuccess || per_cu < 1) fprintf(stderr, "kernel_launch: occupancy query reports %d\n", per_cu);
        (void)hipGetLastError();
        grid = cus;
        if (grid > 256) grid = 256;
        grid &= ~7;
    }
    if (grid <= 0) return;
    (void)hipMemsetAsync((char*)d_ws + WS_CTL, 0, CTL_ZERO_BYTES, stream);
    Args a{};
    for (int i = 0; i < 28; ++i) a.in[i] = (const float*)d_in[i];
    a.out = (float*)d_out; a.ws = (unsigned char*)d_ws;
    if (N_LAUNCHES == 1) { a.ph_lo = 0; a.ph_hi = PER_PHASE; a.li = 0; hipLaunchKernelGGL(mk_fwd, dim3(grid), dim3(NTHR), LDS_BYTES, stream, a); }
    else { for (int li = 0; li < PER_PHASE; ++li) { a.ph_lo = li; a.ph_hi = li + 1; a.li = 0; hipLaunchKernelGGL(mk_fwd, dim3(grid), dim3(NTHR), LDS_BYTES, stream, a); } }
}
```

```cpp
#include <hip/hip_runtime.h>
#include <cstdio>
#include <cstdint>
#include <cmath>

#define LAS __attribute__((address_space(3)))
#define GAS __attribute__((address_space(1)))
typedef unsigned short bf16_t;
typedef short bf16x8 __attribute__((ext_vector_type(8)));
typedef short s16x4 __attribute__((ext_vector_type(4)));
typedef float f32x4 __attribute__((ext_vector_type(4)));
typedef float f32x2 __attribute__((ext_vector_type(2)));
typedef float f32x16 __attribute__((ext_vector_type(16)));
typedef unsigned u32x4 __attribute__((ext_vector_type(4)));
typedef unsigned u32x2 __attribute__((ext_vector_type(2)));
typedef __bf16 bf16x2_t __attribute__((ext_vector_type(2)));

constexpr int D = 1024, SEQ = 8192, NB = 2, MP = NB * SEQ, DB = 32, DS = 16, MS = DB * DS, M = MP + MS;
constexpr int EIN = 1792, FF = 4096, DL = 512, PAST = 4096;
constexpr int C_K = 512, C_V = 640, C_XR = 768, C_GR = 1280;
constexpr float EPS = 1e-6f;
constexpr float SCQ = 0.125f * 1.4426950408889634f;
constexpr float LOG2E = 1.4426950408889634f;

constexpr size_t MiB = 1u << 20;
constexpr size_t WS_CTL = 0, CTL_ZERO_BYTES = 1 * MiB;
constexpr size_t WS_ROPE = 1 * MiB;
constexpr size_t WS_RS0 = 3 * MiB;
constexpr size_t WS_SP8 = WS_RS0 + 128 * 1024;
constexpr size_t WS_CARRY = WS_RS0 + 256 * 1024;
constexpr size_t WS_SSQ = 4 * MiB;
constexpr size_t WS_LNP = 5 * MiB + 512 * 1024;
constexpr size_t WS_W = 8 * MiB;
constexpr size_t WS_WIN_E = WS_W, WS_WOUT_E = WS_WIN_E + (size_t)EIN * D * 2, WS_W1A = WS_WOUT_E + (size_t)D * D * 2, WS_W2A = WS_W1A + (size_t)FF * D * 2,
                 WS_WIN_O = WS_W2A + (size_t)FF * D * 2, WS_WOUT_O = WS_WIN_O + (size_t)2 * D * D * 2, WS_W1B = WS_WOUT_O + (size_t)D * D * 2, WS_W2B = WS_W1B + (size_t)FF * D * 2,
                 WS_GATE = WS_W2B + (size_t)FF * D * 2, WS_SPW = WS_GATE + 16 * 4096 * 2, WS_W_END = WS_SPW + 8 * 128 * 128 * 2;
constexpr size_t WS_YA = 53 * MiB, WS_YB = 86 * MiB, WS_BIG = 119 * MiB, WS_END = 251 * MiB;
constexpr size_t WS_XB = WS_BIG, WS_H1 = WS_BIG + 33 * MiB, WS_AO = WS_BIG + 91 * MiB;
constexpr size_t WS_Z = WS_BIG, WS_AO2 = WS_BIG + 66 * MiB;
static_assert(WS_W_END <= WS_YA && WS_LNP + (size_t)M * 16 * 8 <= WS_W && WS_SSQ + (size_t)M * 64 <= WS_LNP && WS_YA + (size_t)M * D * 2 <= WS_YB && WS_YB + (size_t)M * D * 2 <= WS_BIG, "ws map");
static_assert(WS_H1 + (size_t)M * EIN * 2 <= WS_AO && WS_AO + (size_t)M * D * 2 <= WS_END && WS_BIG + (size_t)M * FF * 2 <= WS_END && WS_XB + (size_t)M * D * 2 <= WS_H1, "ws map 2");
static_assert(WS_CARRY + 2 * 32 * 512 * 8 <= WS_SSQ, "ws map 3");

__device__ __forceinline__ unsigned cvtpk(float lo, float hi) { f32x2 v = {lo, hi}; bf16x2_t b = __builtin_convertvector(v, bf16x2_t); return __builtin_bit_cast(unsigned, b); }
__device__ __forceinline__ float bflo(unsigned u) { return __uint_as_float(u << 16); }
__device__ __forceinline__ float bfhi(unsigned u) { return __uint_as_float(u & 0xffff0000u); }
__device__ __forceinline__ float gelu_t(float x) {
    const float u = x * (0.7978845608f + 0.0356774081f * x * x);
    const float e = __builtin_amdgcn_exp2f(-2.885390082f * u);
    return x * __builtin_amdgcn_rcpf(1.0f + e);
}
__device__ __forceinline__ float sigmoid_f(float z) { return __builtin_amdgcn_rcpf(1.0f + __builtin_amdgcn_exp2f(-LOG2E * z)); }

namespace pg8 {
constexpr int BM = 256, BK = 64, HALF = 128, HTB = HALF * BK * 2, STAGE_BYTES = 8 * HTB, NXCD = 8, WGM = 8;
__host__ __device__ __forceinline__ int lds_byte(int r, int c) { const int st = (r >> 4) * 2 + (c >> 5), rr = r & 15, cc = c & 31, ob = rr * 64 + cc * 2; return st * 1024 + (ob ^ (((ob >> 9) & 1) << 5)); }
__host__ __device__ __forceinline__ void stage_rc(int b, int& R, int& C) { const int st = b / 1024, sb = b % 1024, swz = sb ^ (((sb >> 9) & 1) << 5); R = (st >> 1) * 16 + swz / 64; C = (st & 1) * 32 + (swz % 64) / 2; }
__host__ __device__ __forceinline__ int perm32(int rho) { const int n = rho >> 4, i = rho & 15; return 8 * (i >> 2) + 4 * n + (i & 3); }
struct Unit { int pm, pn; };
struct Gemm { const bf16_t* A; const bf16_t* Bt; int M, N, K; };
struct StaticOrder {
    int nM, nN, nwg, G, c;
    __host__ __device__ void init(int M_, int N_, int G_, int c_) { nM = M_ / BM; nN = N_ / BM; nwg = nM * nN; G = G_; c = c_; }
    __host__ __device__ bool next(int i, Unit& u) const {
        const long L = (long)i * G + c; if (L >= nwg) return false;
        int wgid = (int)L; { const int q = nwg / NXCD, r = nwg % NXCD, xcd = wgid % NXCD, off = wgid / NXCD; wgid = (xcd < r ? xcd * (q + 1) : r * (q + 1) + (xcd - r) * q) + off; }
        const int nig = WGM * nN, gid = wgid / nig, fm = gid * WGM, gsz = (nM - fm) < WGM ? (nM - fm) : WGM;
        u.pm = fm + ((wgid % nig) % gsz); u.pn = (wgid % nig) / gsz; return true;
    }
    __device__ __forceinline__ void a_ready(const Unit&) const {}
    __device__ __forceinline__ void done(const Unit&) const {}
};

__device__ __forceinline__ int row_pos(int r) { return r < MP ? (r & (SEQ - 1)) : PAST + ((r - MP) & (DS - 1)); }

struct EpiIn {
    static constexpr int PERM = 2; static constexpr bool AFTER_DRAIN = false;
    bf16_t* H1; const float* rs0; const f32x4* rope; const float* qg; const float* kg; float* out;
    static constexpr size_t O_KP = (size_t)M * D, O_VP = O_KP + 32768, O_HP = O_VP + 32768, O_CP = O_HP + 1024, O_KS = O_CP + 3072, O_VS = O_KS + 524288, O_HS = O_VS + 524288, O_CS = O_HS + 16384, O_GV = O_CS + 49152;
    __device__ __forceinline__ void operator()(const f32x4 (&acc)[2][2][4][2], const Unit& u, int wr, int wc, int fr, int fq) const {
        const int pn = u.pn;
        const int kind = pn < 2 ? 0 : (pn == 2 ? (wc < 2 ? 1 : 2) : (pn < 5 ? 3 : 4));
        const int colb = pn * 256 + 64 * wc + 8 * fq;
        f32x4 g[2][2];
        if (kind <= 1) { const float* gp = (kind == 0 ? qg : kg) + 8 * fq;
#pragma unroll
            for (int bj = 0; bj < 2; ++bj)
#pragma unroll
                for (int n = 0; n < 2; ++n) g[bj][n] = *(const f32x4*)(gp + 32 * bj + 4 * n); }
        const float qs = kind == 0 ? SCQ : 1.0f;
#pragma unroll
        for (int ai = 0; ai < 2; ++ai)
#pragma unroll
            for (int m = 0; m < 4; ++m) {
                const int r = u.pm * BM + ai * HALF + wr * 64 + m * 16 + fr;
                const float rs = rs0[r];
                f32x4 x[2][2];
#pragma unroll
                for (int bj = 0; bj < 2; ++bj)
#pragma unroll
                    for (int n = 0; n < 2; ++n) x[bj][n] = acc[ai][bj][m][n] * rs;
                f32x4 of[2][2];
                if (kind <= 1) {
                    float ss = 0.f;
#pragma unroll
                    for (int bj = 0; bj < 2; ++bj)
#pragma unroll
                        for (int n = 0; n < 2; ++n) ss += (x[bj][n][0] * x[bj][n][0] + x[bj][n][1] * x[bj][n][1]) + (x[bj][n][2] * x[bj][n][2] + x[bj][n][3] * x[bj][n][3]);
                    ss += __shfl_xor(ss, 16); ss += __shfl_xor(ss, 32);
                    const float rinv = __builtin_amdgcn_rsqf(ss * (1.0f / 64.0f) + EPS);
                    const f32x4* cs = rope + (size_t)row_pos(r) * 16 + 4 * fq;
#pragma unroll
                    for (int n = 0; n < 2; ++n) {
                        const f32x4 c01 = cs[2 * n], c23 = cs[2 * n + 1];
                        const float co[4] = {c01[0], c01[2], c23[0], c23[2]}, si[4] = {c01[1], c01[3], c23[1], c23[3]};
#pragma unroll
                        for (int e = 0; e < 4; ++e) {
                            const float x1 = x[0][n][e] * rinv * g[0][n][e], x2 = x[1][n][e] * rinv * g[1][n][e];
                            of[0][n][e] = x1 * co[e] - x2 * si[e]; of[1][n][e] = x2 * co[e] + x1 * si[e];
                        }
                    }
                } else if (kind == 4) {
#pragma unroll
                    for (int bj = 0; bj < 2; ++bj)
#pragma unroll
                        for (int n = 0; n < 2; ++n)
#pragma unroll
                            for (int e = 0; e < 4; ++e) of[bj][n][e] = gelu_t(x[bj][n][e]);
                } else {
#pragma unroll
                    for (int bj = 0; bj < 2; ++bj)
#pragma unroll
                        for (int n = 0; n < 2; ++n) of[bj][n] = x[bj][n];
                }
                bf16_t* rowp = H1 + (size_t)r * EIN + colb;
#pragma unroll
                for (int bj = 0; bj < 2; ++bj) { u32x4 w; w.x = cvtpk(of[bj][0][0] * qs, of[bj][0][1] * qs); w.y = cvtpk(of[bj][0][2] * qs, of[bj][0][3] * qs); w.z = cvtpk(of[bj][1][0] * qs, of[bj][1][1] * qs); w.w = cvtpk(of[bj][1][2] * qs, of[bj][1][3] * qs);
                    *(u32x4*)(rowp + 32 * bj) = w; }
                if (kind == 1 || kind == 2) {
                    const int kh = wc & 1; float* dst = nullptr;
                    if (r < MP) { const int t = r & (SEQ - 1), b = r >> 13; if (t >= SEQ - 128) dst = out + (kind == 1 ? O_KP : O_VP) + ((size_t)(b * 128 + (t - (SEQ - 128))) * 2 + kh) * 64; }
                    else { const int rr = r - MP, b = rr >> 4, t = rr & 15; dst = out + (kind == 1 ? O_KS : O_VS) + ((size_t)(b * 128 + 112 + t) * 2 + kh) * 64; }
                    if (dst) {
#pragma unroll
                        for (int bj = 0; bj < 2; ++bj)
#pragma unroll
                            for (int n = 0; n < 2; ++n) *(f32x4*)(dst + 32 * bj + 8 * fq + 4 * n) = of[bj][n]; }
                } else if (kind == 3) {
                    const int ch = (pn - 3) * 256 + 64 * wc + 8 * fq; float* dst = nullptr;
                    if (r < MP) { const int t = r & (SEQ - 1), b = r >> 13; if (t >= SEQ - 3) dst = out + O_CP + (size_t)(b * 3 + (t - (SEQ - 3))) * 512 + ch; }
                    else { const int rr = r - MP, b = rr >> 4, t = rr & 15; if (t >= DS - 3) dst = out + O_CS + (size_t)(b * 3 + (t - (DS - 3))) * 512 + ch; }
                    if (dst) {
#pragma unroll
                        for (int bj = 0; bj < 2; ++bj)
#pragma unroll
                            for (int n = 0; n < 2; ++n) *(f32x4*)(dst + 32 * bj + 4 * n) = of[bj][n]; }
                }
            }
    }
};
template <bool RES_F32> struct EpiRes {
    static constexpr int PERM = 1; static constexpr bool AFTER_DRAIN = false;
    const float* xp; const float* xs; const bf16_t* rb; bf16_t* Y; float* ssq;
    __device__ __forceinline__ void operator()(const f32x4 (&acc)[2][2][4][2], const Unit& u, int wr, int wc, int fr, int fq) const {
        const int col0 = u.pn * BM + wc * 32 + 8 * fq;
#pragma unroll
        for (int ai = 0; ai < 2; ++ai)
#pragma unroll
            for (int m = 0; m < 4; ++m) {
                const int r = u.pm * BM + ai * HALF + wr * 64 + m * 16 + fr; float s = 0.f;
#pragma unroll
                for (int bj = 0; bj < 2; ++bj) {
                    f32x4 r0, r1;
                    if (RES_F32) { const float* p = (r < MP ? xp + (size_t)r * D : xs + (size_t)(r - MP) * D) + col0 + bj * HALF; r0 = *(const f32x4*)p; r1 = *(const f32x4*)(p + 4); }
                    else { const u32x4 w = *(const u32x4*)(rb + (size_t)r * D + col0 + bj * HALF); r0 = (f32x4){bflo(w.x), bfhi(w.x), bflo(w.y), bfhi(w.y)}; r1 = (f32x4){bflo(w.z), bfhi(w.z), bflo(w.w), bfhi(w.w)}; }
                    const f32x4 y0 = r0 + acc[ai][bj][m][0], y1 = r1 + acc[ai][bj][m][1];
                    s += (y0[0] * y0[0] + y0[1] * y0[1]) + (y0[2] * y0[2] + y0[3] * y0[3]) + (y1[0] * y1[0] + y1[1] * y1[1]) + (y1[2] * y1[2] + y1[3] * y1[3]);
                    u32x4 w; w.x = cvtpk(y0[0], y0[1]); w.y = cvtpk(y0[2], y0[3]); w.z = cvtpk(y1[0], y1[1]); w.w = cvtpk(y1[2], y1[3]);
                    *(u32x4*)(Y + (size_t)r * D + col0 + bj * HALF) = w;
                }
                s += __shfl_xor(s, 16); s += __shfl_xor(s, 32);
                if (fq == 0) ssq[(size_t)r * 16 + u.pn * 4 + wc] = s;
            }
    }
};
__device__ __forceinline__ float row_rs(const float* ssq, int r) {
    const f32x4* p = (const f32x4*)(ssq + (size_t)r * 16); const f32x4 a = p[0], b = p[1], c = p[2], d = p[3];
    const float s = ((a[0] + a[1]) + (a[2] + a[3])) + ((b[0] + b[1]) + (b[2] + b[3])) + ((c[0] + c[1]) + (c[2] + c[3])) + ((d[0] + d[1]) + (d[2] + d[3]));
    return __builtin_amdgcn_rsqf(s * (1.0f / D) + EPS);
}
template <int ACT> struct EpiAct {
    static constexpr int PERM = 1; static constexpr bool AFTER_DRAIN = false;
    const float* ssq; bf16_t* O; int ldc; f32x2* lnp;
    __device__ __forceinline__ void operator()(const f32x4 (&acc)[2][2][4][2], const Unit& u, int wr, int wc, int fr, int fq) const {
        const int col0 = u.pn * BM + wc * 32 + 8 * fq;
#pragma unroll
        for (int ai = 0; ai < 2; ++ai)
#pragma unroll
            for (int m = 0; m < 4; ++m) {
                const int r = u.pm * BM + ai * HALF + wr * 64 + m * 16 + fr; const float rs = row_rs(ssq, r); float s1 = 0.f, s2 = 0.f;
#pragma unroll
                for (int bj = 0; bj < 2; ++bj) {
                    f32x4 v0 = acc[ai][bj][m][0] * rs, v1 = acc[ai][bj][m][1] * rs;
#pragma unroll
                    for (int e = 0; e < 4; ++e) {
                        if (ACT == 0) { const float a = fmaxf(v0[e], 0.f), b = fmaxf(v1[e], 0.f); v0[e] = a * a; v1[e] = b * b; }
                        else { v0[e] = gelu_t(v0[e]); v1[e] = gelu_t(v1[e]); }
                    }
                    if (ACT == 1) { s1 += (v0[0] + v0[1]) + (v0[2] + v0[3]) + (v1[0] + v1[1]) + (v1[2] + v1[3]);
                        s2 += (v0[0] * v0[0] + v0[1] * v0[1]) + (v0[2] * v0[2] + v0[3] * v0[3]) + (v1[0] * v1[0] + v1[1] * v1[1]) + (v1[2] * v1[2] + v1[3] * v1[3]); }
                    u32x4 w; w.x = cvtpk(v0[0], v0[1]); w.y = cvtpk(v0[2], v0[3]); w.z = cvtpk(v1[0], v1[1]); w.w = cvtpk(v1[2], v1[3]);
                    *(u32x4*)(O + (size_t)r * ldc + col0 + bj * HALF) = w;
                }
                if (ACT == 1 && u.pn >= 4) { s1 += __shfl_xor(s1, 16); s1 += __shfl_xor(s1, 32); s2 += __shfl_xor(s2, 16); s2 += __shfl_xor(s2, 32);
                    if (fq == 0) lnp[(size_t)r * 16 + (u.pn - 4) * 4 + wc] = (f32x2){s1, s2}; }
            }
    }
};
struct EpiOut {
    static constexpr int PERM = 0; static constexpr bool AFTER_DRAIN = false;
    const bf16_t* rb; float* out;
    __device__ __forceinline__ void operator()(const f32x4 (&acc)[2][2][4][2], const Unit& u, int wr, int wc, int fr, int fq) const {
        const int col0 = u.pn * BM + wc * 32 + 4 * fq;
#pragma unroll
        for (int ai = 0; ai < 2; ++ai)
#pragma unroll
            for (int m = 0; m < 4; ++m) {
                const size_t off = (size_t)(u.pm * BM + ai * HALF + wr * 64 + m * 16 + fr) * D + col0;
#pragma unroll
                for (int bj = 0; bj < 2; ++bj)
#pragma unroll
                    for (int n = 0; n < 2; ++n) { const u32x2 w = *(const u32x2*)(rb + off + bj * HALF + n * 16);
                        const f32x4 rv = {bflo(w.x), bfhi(w.x), bflo(w.y), bfhi(w.y)}; *(f32x4*)(out + off + bj * HALF + n * 16) = rv + acc[ai][bj][m][n]; }
            }
    }
};

template <class Epi, class Sched, bool ALIGN_EPI = false, bool SP2 = false>
__device__ __forceinline__ void gemm_phase(LAS unsigned char* lds, const Gemm g, const Sched& S, const Epi& E) {
    const int tid = threadIdx.x, wid = __builtin_amdgcn_readfirstlane(tid >> 6), lane = tid & 63, wr = wid >> 2, wc = wid & 3, fr = lane & 15, fq = lane >> 4;
    const int K = g.K, nt = K / BK;
    unsigned voffA[2], voffB[2], voffB1[2];
#pragma unroll
    for (int i = 0; i < 2; ++i) { int R, C; stage_rc(tid * 16 + i * 8192, R, C);
        int Rb0, Rb1;
        if (Epi::PERM == 0) { Rb0 = R; Rb1 = HALF + R; }
        else if (Epi::PERM == 1) { Rb0 = (R & ~31) + perm32(R & 31); Rb1 = HALF + Rb0; }
        else { Rb0 = 64 * (R >> 5) + perm32(R & 31); Rb1 = Rb0 + 32; }
        voffA[i] = (unsigned)(R * K + C) * 2u; voffB[i] = (unsigned)(Rb0 * K + C) * 2u; voffB1[i] = (unsigned)(Rb1 * K + C) * 2u; }
    const size_t kstep = (size_t)(BK * 2);
    const size_t hstep = (size_t)HALF * K * 2;
    const size_t tstep = 2 * hstep;
    const unsigned ldsw = (unsigned)wid * 1024u;
    const int aoff = lds_byte(wr * 64 + fr, fq * 8), boff = lds_byte(wc * 32 + fr, fq * 8);
#define PG8_SA(b, h) (((b) * 2 + (h)) * HTB)
#define PG8_SB(b, h) ((4 + (b) * 2 + (h)) * HTB)
#define PG8_STAGE(bufoff, gbase, voff) do { _Pragma("unroll") for (int _i = 0; _i < 2; ++_i) \
        __builtin_amdgcn_global_load_lds((const unsigned*)((const char*)(gbase) + (voff)[_i]), (LAS unsigned*)(lds + (bufoff) + ldsw + _i * 8192), 16, 0, 0); } while (0)
#define PG8_LDA(dst, b, h) do { _Pragma("unroll") for (int m = 0; m < 4; ++m) _Pragma("unroll") for (int k = 0; k < 2; ++k) dst[m][k] = *(const LAS bf16x8*)(lds + PG8_SA(b, h) + aoff + m * 2048 + k * 1024); } while (0)
#define PG8_LDB(dst, b, h) do { _Pragma("unroll") for (int n = 0; n < 2; ++n) _Pragma("unroll") for (int k = 0; k < 2; ++k) dst[n][k] = *(const LAS bf16x8*)(lds + PG8_SB(b, h) + boff + n * 2048 + k * 1024); } while (0)
#define PG8_MMA(ai, bj, At, Bt) do { __builtin_amdgcn_s_setprio(1); _Pragma("unroll") for (int m = 0; m < 4; ++m) _Pragma("unroll") for (int n = 0; n < 2; ++n) _Pragma("unroll") for (int k = 0; k < 2; ++k) \
        acc[ai][bj][m][n] = __builtin_amdgcn_mfma_f32_16x16x32_bf16(Bt[n][k], At[m][k], acc[ai][bj][m][n], 0, 0, 0); __builtin_amdgcn_s_setprio(0); } while (0)
#define PG8_WAIT_V(n) asm volatile("s_waitcnt vmcnt(" #n ")" ::: "memory")
#define PG8_WAIT_L(n) asm volatile("s_waitcnt lgkmcnt(" #n ")" ::: "memory")
#define PG8_BAR __builtin_amdgcn_s_barrier()
#define PG8_SCHED __builtin_amdgcn_sched_barrier(0)
    Unit cur, nxt; int ui = 0;
    if (!S.next(0, cur)) return;
    f32x4 acc[2][2][4][2];
#pragma unroll
    for (int a = 0; a < 2; ++a)
#pragma unroll
        for (int b = 0; b < 2; ++b)
#pragma unroll
            for (int m = 0; m < 4; ++m)
#pragma unroll
                for (int n = 0; n < 2; ++n) acc[a][b][m][n] = (f32x4){0.f, 0.f, 0.f, 0.f};
    bf16x8 At[4][2], B0[2][2], B1[2][2];
    const char* cA = (const char*)g.A + (size_t)cur.pm * tstep; const char* cB = (const char*)g.Bt + (size_t)cur.pn * tstep;
    S.a_ready(cur);
    if constexpr (SP2) {
        PG8_STAGE(PG8_SB(0, 0), cB, voffB); PG8_STAGE(PG8_SB(0, 1), cB, voffB1); PG8_STAGE(PG8_SA(0, 0), cA, voffA); PG8_STAGE(PG8_SA(0, 1), cA + hstep, voffA);
        if (wr == 1) PG8_BAR;
        PG8_WAIT_V(2); PG8_BAR;
        PG8_STAGE(PG8_SB(1, 0), cB + kstep, voffB); PG8_STAGE(PG8_SA(1, 0), cA + kstep, voffA); PG8_STAGE(PG8_SB(1, 1), cB + kstep, voffB1);
        PG8_WAIT_V(6); PG8_BAR;
    } else {
        PG8_STAGE(PG8_SB(0, 0), cB, voffB); PG8_STAGE(PG8_SA(0, 0), cA, voffA); PG8_STAGE(PG8_SB(0, 1), cB, voffB1); PG8_STAGE(PG8_SA(0, 1), cA + hstep, voffA);
        if (wr == 1) PG8_BAR;
        PG8_WAIT_V(4); PG8_BAR;
        PG8_STAGE(PG8_SB(1, 0), cB + kstep, voffB); PG8_STAGE(PG8_SA(1, 0), cA + kstep, voffA); PG8_STAGE(PG8_SB(1, 1), cB + kstep, voffB1);
        PG8_WAIT_V(6); PG8_BAR;
    }
    for (;;) {
        const bool has_next = S.next(ui + 1, nxt);
        const char* nA = has_next ? (const char*)g.A + (size_t)nxt.pm * tstep : cA; const char* nB = has_next ? (const char*)g.Bt + (size_t)nxt.pn * tstep : cB;
        for (int t = 0; t < nt; t += 2) {
            const bool last = (t == nt - 2);
            const char* a1 = cA + (size_t)(t + 1) * kstep;
            const char* a2 = last ? nA : cA + (size_t)(t + 2) * kstep; const char* b2 = last ? nB : cB + (size_t)(t + 2) * kstep;
            const char* a3 = a2 + kstep; const char* b3 = b2 + kstep;
            if (last && has_next) S.a_ready(nxt);
            if constexpr (SP2) {
            PG8_LDB(B0, 0, 0); PG8_LDB(B1, 0, 1); PG8_SCHED; PG8_LDA(At, 0, 0); PG8_STAGE(PG8_SA(1, 1), a1 + hstep, voffA);
            PG8_WAIT_V(8); PG8_WAIT_L(0); PG8_BAR; PG8_MMA(0, 0, At, B0); PG8_MMA(0, 1, At, B1); PG8_BAR; PG8_SCHED;
            PG8_LDA(At, 0, 1); PG8_STAGE(PG8_SB(0, 0), b2, voffB); PG8_STAGE(PG8_SB(0, 1), b2, voffB1); PG8_STAGE(PG8_SA(0, 0), a2, voffA);
            PG8_WAIT_V(8); PG8_WAIT_L(0); PG8_BAR; PG8_MMA(1, 0, At, B0); PG8_MMA(1, 1, At, B1); PG8_BAR; PG8_SCHED;
            PG8_LDB(B0, 1, 0); PG8_LDB(B1, 1, 1); PG8_SCHED; PG8_LDA(At, 1, 0); PG8_STAGE(PG8_SA(0, 1), a2 + hstep, voffA);
            PG8_WAIT_V(8); PG8_WAIT_L(0); PG8_BAR; PG8_MMA(0, 0, At, B0); PG8_MMA(0, 1, At, B1); PG8_BAR; PG8_SCHED;
            PG8_LDA(At, 1, 1); PG8_STAGE(PG8_SB(1, 0), b3, voffB); PG8_STAGE(PG8_SB(1, 1), b3, voffB1); PG8_STAGE(PG8_SA(1, 0), a3, voffA);
            PG8_WAIT_V(8); PG8_WAIT_L(0); PG8_BAR; PG8_MMA(1, 0, At, B0); PG8_MMA(1, 1, At, B1); PG8_BAR; PG8_SCHED;
            } else {
            PG8_LDB(B0, 0, 0); PG8_SCHED; PG8_LDA(At, 0, 0); PG8_STAGE(PG8_SA(1, 1), a1 + hstep, voffA);
            PG8_WAIT_L(8); PG8_BAR; PG8_WAIT_L(0); PG8_MMA(0, 0, At, B0); PG8_BAR; PG8_SCHED;
            PG8_LDB(B1, 0, 1); PG8_STAGE(PG8_SB(0, 0), b2, voffB);
            PG8_BAR; PG8_WAIT_L(0); PG8_MMA(0, 1, At, B1); PG8_BAR;
            PG8_LDA(At, 0, 1); PG8_STAGE(PG8_SA(0, 0), a2, voffA);
            PG8_BAR; PG8_WAIT_L(0); PG8_MMA(1, 0, At, B0); PG8_BAR; PG8_SCHED;
            PG8_STAGE(PG8_SB(0, 1), b2, voffB1);
            PG8_WAIT_V(6); PG8_BAR; PG8_MMA(1, 1, At, B1); PG8_BAR;
            PG8_LDB(B0, 1, 0); PG8_SCHED; PG8_LDA(At, 1, 0); PG8_STAGE(PG8_SA(0, 1), a2 + hstep, voffA);
            PG8_WAIT_L(8); PG8_BAR; PG8_WAIT_L(0); PG8_MMA(0, 0, At, B0); PG8_BAR; PG8_SCHED;
            PG8_LDB(B1, 1, 1); PG8_STAGE(PG8_SB(1, 0), b3, voffB);
            PG8_BAR; PG8_WAIT_L(0); PG8_MMA(0, 1, At, B1); PG8_BAR;
            PG8_LDA(At, 1, 1); PG8_STAGE(PG8_SA(1, 0), a3, voffA);
            PG8_BAR; PG8_WAIT_L(0); PG8_MMA(1, 0, At, B0); PG8_BAR; PG8_SCHED;
            PG8_STAGE(PG8_SB(1, 1), b3, voffB1);
            PG8_WAIT_V(6); PG8_BAR; PG8_MMA(1, 1, At, B1); PG8_BAR;
            }
        }
        if constexpr (ALIGN_EPI) { if (wr == 0) PG8_BAR; }
        if constexpr (!Epi::AFTER_DRAIN) { E(acc, cur, wr, wc, fr, fq); S.done(cur); }
        if (!has_next) break;
#pragma unroll
        for (int a = 0; a < 2; ++a)
#pragma unroll
            for (int b = 0; b < 2; ++b)
#pragma unroll
                for (int m = 0; m < 4; ++m)
#pragma unroll
                    for (int n = 0; n < 2; ++n) acc[a][b][m][n] = (f32x4){0.f, 0.f, 0.f, 0.f};
        cur = nxt; cA = nA; cB = nB; ++ui;
        if constexpr (ALIGN_EPI) { if (wr == 1) PG8_BAR; }
    }
    PG8_WAIT_V(0);
    if constexpr (!ALIGN_EPI) { if (wr == 0) PG8_BAR; }
    PG8_BAR;
#undef PG8_SA
#undef PG8_SB
#undef PG8_STAGE
#undef PG8_LDA
#undef PG8_LDB
#undef PG8_MMA
#undef PG8_WAIT_V
#undef PG8_WAIT_L
#undef PG8_BAR
#undef PG8_SCHED
}
}

constexpr int NWAVES = 8, NTHR = NWAVES * 64;
#ifndef MK_N_LAUNCHES
#define MK_N_LAUNCHES 1
#endif
constexpr int N_LAUNCHES = MK_N_LAUNCHES;
constexpr int PER_PHASE = 12;
constexpr int CW_TMO = 0, CW_CODE = 1, CW_BAR = 4096;
constexpr int RING_OFF = 0, RING_BYTES = 131072, LDSCTL_OFF = RING_BYTES, MISC_OFF = LDSCTL_OFF + 320, LDS_BYTES = 147456;

typedef GAS unsigned gu32;
#define RLX_AGENT __ATOMIC_RELAXED, __HIP_MEMORY_SCOPE_AGENT
#define LDS_WAIT() asm volatile("s_waitcnt lgkmcnt(0)" ::: "memory")
#define VM_WAIT() asm volatile("s_waitcnt vmcnt(0)" ::: "memory")

#define XB_TMO      128
#define XB_XCNT(j)  (256  + 64 * (j))
#define XB_XSUB(j)  (1280 + 64 * (j))
#define XB_XGEN(j)  (2304 + 64 * (j))
#define XB_TOP      3328
#define XB_TOPGEN   3392
#define XCD_BAR_WORDS 3456
#define XB_SPIN_CAP (1u << 18)
__device__ __forceinline__ unsigned xb_ld(unsigned* p)              { return __hip_atomic_load(p, __ATOMIC_RELAXED, __HIP_MEMORY_SCOPE_AGENT); }
__device__ __forceinline__ unsigned xb_add(unsigned* p, unsigned v) { return __hip_atomic_fetch_add(p, v, __ATOMIC_RELAXED, __HIP_MEMORY_SCOPE_AGENT); }
__device__ __forceinline__ unsigned xb_xcc_id() { return (unsigned)__builtin_amdgcn_s_getreg((3 << 11) | 20) & 0xFu; }
#define XB_SPIN(cond, bar) do { unsigned _sp = 0; while (cond) { __builtin_amdgcn_s_sleep(1); \
    if ((++_sp & 255u) == 0u) { if (xb_ld(&(bar)[XB_TMO])) break; if (_sp > XB_SPIN_CAP) { atomicAdd(&(bar)[XB_TMO], 1u); break; } } } } while (0)
struct XcdBarrier { unsigned* bar; unsigned x; volatile LAS unsigned* st; };
__device__ __forceinline__ XcdBarrier xcd_barrier_post(unsigned* bar, volatile LAS unsigned* st) {
    XcdBarrier b; b.bar = bar; b.x = xb_xcc_id(); b.st = st;
    if (threadIdx.x == 0) (void)xb_add(&bar[XB_XCNT(b.x)], 1u);
    return b;
}
__device__ __forceinline__ void xcd_barrier_complete(unsigned* bar, unsigned x, unsigned& nloc, unsigned& nx) {
    const unsigned G = gridDim.x * gridDim.y * gridDim.z;
    unsigned sum, cnt, mine, sp = 0u;
    for (;;) {
        sum = 0u; cnt = 0u; mine = 0u;
#pragma unroll
        for (unsigned j = 0; j < 16; ++j) { const unsigned c = xb_ld(&bar[XB_XCNT(j)]); sum += c; cnt += (c > 0u) ? 1u : 0u; mine = (j == x) ? c : mine; }
        if (sum == G) break;
        __builtin_amdgcn_s_sleep(1);
        if ((++sp & 255u) == 0u) { if (xb_ld(&bar[XB_TMO])) break; if (sp > XB_SPIN_CAP) { atomicAdd(&bar[XB_TMO], 1u); break; } }
    }
    nloc = mine > 0u ? mine : 1u; nx = cnt > 0u ? cnt : 1u;
}
__device__ __forceinline__ void xcd_barrier(const XcdBarrier& b) {
    asm volatile("s_waitcnt vmcnt(0)" ::: "memory");
    __syncthreads();
    if (threadIdx.x == 0) {
        unsigned* bar = b.bar;
        __builtin_amdgcn_s_waitcnt(0);
        unsigned nloc = b.st[0], nx = b.st[1];
        if (nloc == 0u) { xcd_barrier_complete(bar, b.x, nloc, nx); b.st[0] = nloc; b.st[1] = nx; }
        const unsigned old = xb_add(&bar[XB_XSUB(b.x)], 1u);
        const unsigned gen = old / nloc;
        if (old + 1u == (gen + 1u) * nloc) {
            __builtin_amdgcn_fence(__ATOMIC_RELEASE, "agent");
            asm volatile("s_waitcnt vmcnt(0)" ::: "memory");
            const unsigned og = xb_add(&bar[XB_TOP], 1u);
            const unsigned tg = og / nx;
            if (og + 1u == (tg + 1u) * nx) xb_add(&bar[XB_TOPGEN], 1u);
            else XB_SPIN(xb_ld(&bar[XB_TOPGEN]) == tg, bar);
            __builtin_amdgcn_fence(__ATOMIC_ACQUIRE, "agent");
            xb_add(&bar[XB_XGEN(b.x)], 1u);
            asm volatile("s_waitcnt vmcnt(0)" ::: "memory");
        } else {
            XB_SPIN(xb_ld(&bar[XB_XGEN(b.x)]) == gen, bar);
            __builtin_amdgcn_fence(__ATOMIC_ACQUIRE, "agent");
            asm volatile("s_waitcnt vmcnt(0)" ::: "memory");
        }
    }
    __syncthreads();
}

struct Args { const float* in[28]; float* out; unsigned char* ws; int ph_lo, ph_hi, li, pad; };

__device__ __forceinline__ float wave_sum(float v) {
#pragma unroll
    for (int o = 1; o < 64; o <<= 1) v += __shfl_xor(v, o);
    return v;
}

__device__ __forceinline__ void p0_transpose_item(const float* W, int K, int N, bf16_t* WT, const float* g, LAS float* scr, int item, int lane) {
    const int nblk = N / 32, kb = item / nblk, nb = item % nblk, k0 = 64 * kb, n0 = 32 * nb;
#pragma unroll 8
    for (int i = 0; i < 32; ++i) { const int kk = 2 * i + (lane >> 5); const float gv = g ? g[k0 + kk] : 1.0f; scr[kk * 33 + (lane & 31)] = W[(size_t)(k0 + kk) * N + n0 + (lane & 31)] * gv; }
    LDS_WAIT(); asm volatile("" ::: "memory");
    const int c = lane & 7;
#pragma unroll
    for (int j = 0; j < 4; ++j) { const int n = (lane >> 3) + 8 * j; const LAS float* s = scr + (8 * c) * 33 + n;
        u32x4 o; o.x = cvtpk(s[0 * 33], s[1 * 33]); o.y = cvtpk(s[2 * 33], s[3 * 33]); o.z = cvtpk(s[4 * 33], s[5 * 33]); o.w = cvtpk(s[6 * 33], s[7 * 33]);
        *(GAS u32x4*)(WT + (size_t)(n0 + n) * K + k0 + 8 * c) = o; }
    LDS_WAIT(); asm volatile("" ::: "memory");
}

__device__ __forceinline__ void p0_prologue(const Args& a, LAS unsigned char* lds, int vcu, int G, int tid, int lane, int wave) {
    unsigned char* ws = a.ws;
    LAS float* scr = (LAS float*)(lds + RING_OFF + wave * 16384);
    const int gw = vcu * NWAVES + wave, NGW = G * NWAVES;
    constexpr int I_WIN = 16 * 56, I_WOUT = 16 * 32, I_W1 = 16 * 128, I_W2 = 64 * 32, I_WINO = 16 * 64, I_GATE = 2;
    constexpr int NITEMS = I_WIN + I_WOUT + 2 * I_W1 + 2 * I_W2 + I_WINO + I_WOUT + 16 * I_GATE;
    for (int it = gw; it < NITEMS; it += NGW) {
        int r = it;
        if (r < I_WIN) { p0_transpose_item(a.in[7], D, EIN, (bf16_t*)(ws + WS_WIN_E), a.in[6], scr, r, lane); continue; } r -= I_WIN;
        if (r < I_WOUT) { p0_transpose_item(a.in[18], D, D, (bf16_t*)(ws + WS_WOUT_E), nullptr, scr, r, lane); continue; } r -= I_WOUT;
        if (r < I_W1) { p0_transpose_item(a.in[26], D, FF, (bf16_t*)(ws + WS_W1A), a.in[25], scr, r, lane); continue; } r -= I_W1;
        if (r < I_W1) { p0_transpose_item(a.in[26] + (size_t)D * FF, D, FF, (bf16_t*)(ws + WS_W1B), a.in[25] + D, scr, r, lane); continue; } r -= I_W1;
        if (r < I_W2) { p0_transpose_item(a.in[27], FF, D, (bf16_t*)(ws + WS_W2A), nullptr, scr, r, lane); continue; } r -= I_W2;
        if (r < I_W2) { p0_transpose_item(a.in[27] + (size_t)D * FF, FF, D, (bf16_t*)(ws + WS_W2B), nullptr, scr, r, lane); continue; } r -= I_W2;
        if (r < I_WINO) { p0_transpose_item(a.in[20], D, 2 * D, (bf16_t*)(ws + WS_WIN_O), a.in[19], scr, r, lane); continue; } r -= I_WINO;
        if (r < I_WOUT) { p0_transpose_item(a.in[24], D, D, (bf16_t*)(ws + WS_WOUT_O), nullptr, scr, r, lane); continue; } r -= I_WOUT;
        { const int blk = r >> 1, sub = r & 1;
          const float* src = (blk < 8 ? a.in[13] : a.in[15]) + (size_t)(blk & 7) * 4096;
          p0_transpose_item(src, 64, 64, (bf16_t*)(ws + WS_GATE) + (size_t)blk * 4096, nullptr, scr, sub, lane); }
    }
    for (int m = gw; m < M; m += NGW) {
        const float* xrow = (m < MP) ? a.in[0] + (size_t)m * D : a.in[1] + (size_t)(m - MP) * D;
        const GAS f32x4* xr = (const GAS f32x4*)xrow + lane;
        f32x4 v[4]; float s = 0.f;
#pragma unroll
        for (int j = 0; j < 4; ++j) { v[j] = xr[64 * j]; s += (v[j][0] * v[j][0] + v[j][1] * v[j][1]) + (v[j][2] * v[j][2] + v[j][3] * v[j][3]); }
        s = wave_sum(s);
        if (lane == 0) ((float*)(ws + WS_RS0))[m] = __builtin_amdgcn_rsqf(s * (1.0f / D) + EPS);
        GAS u32x2* o8 = (GAS u32x2*)((bf16_t*)(ws + WS_XB) + (size_t)m * D) + lane;
#pragma unroll
        for (int j = 0; j < 4; ++j) o8[64 * j] = (u32x2){cvtpk(v[j][0], v[j][1]), cvtpk(v[j][2], v[j][3])};
    }
    const int gt = vcu * NTHR + tid, NGT = G * NTHR;
    for (int i = gt; i < SEQ * 32; i += NGT) {
        const int pos = i >> 5, k = i & 31;
        const float inv = (float)exp2(-(double)k * (13.287712379549449 / 32.0));
        const float ang = (float)pos * inv;
        double sn, cn; sincos((double)ang, &sn, &cn);
        ((f32x2*)(ws + WS_ROPE))[i] = (f32x2){(float)cn, (float)sn};
    }
    for (int i = gt; i < DL; i += NGT) { const double l = (double)a.in[17][i]; ((float*)(ws + WS_SP8))[i] = (float)(8.0 * log1p(exp(-l))); }
    for (int i = gt; i < 8 * 128 * 128; i += NGT) { const int t = (i >> 7) & 127, s = i & 127; const float w = (s <= t) ? a.in[22][i] : 0.f; ((bf16_t*)(ws + WS_SPW))[i] = (bf16_t)(cvtpk(w, 0.f) & 0xffffu); }
    for (int i = gt; i < DB * 112 * 32; i += NGT) {
        const int b = i / 3584, q = i % 3584;
        const f32x4 kv = ((const f32x4*)a.in[2])[(size_t)b * 4096 + 512 + q], vv = ((const f32x4*)a.in[3])[(size_t)b * 4096 + 512 + q];
        ((f32x4*)(a.out + pg8::EpiIn::O_KS))[(size_t)b * 4096 + q] = kv; ((f32x4*)(a.out + pg8::EpiIn::O_VS))[(size_t)b * 4096 + q] = vv;
    }
}

constexpr int AT_KS = 0, AT_VT = 24576, AT_VTS = 392;
__device__ __forceinline__ int crow(int r, int hi) { return (r & 3) + 8 * (r >> 2) + 4 * hi; }
template <bool SAMPLE>
__device__ __forceinline__ void attn_unit(const Args& a, LAS unsigned char* lds, int b, int c, int kh, int tid, int lane, int wave) {
    constexpr int NKT = SAMPLE ? 5 : 6, NROW = NKT * 32;
    const bf16_t* H1 = (const bf16_t*)(a.ws + WS_H1);
    for (int idx = tid; idx < NROW * 8; idx += NTHR) {
        const int row = idx >> 3, ch = idx & 7;
        u32x4 kq = {0u, 0u, 0u, 0u}, vq = {0u, 0u, 0u, 0u};
        if (!SAMPLE) {
            const int t = (c - 2) * 64 + row;
            if (t >= 0) { const bf16_t* p = H1 + (size_t)(b * SEQ + t) * EIN + 64 * kh + 8 * ch; kq = *(const u32x4*)(p + C_K); vq = *(const u32x4*)(p + C_V); }
        } else {
            if (row < 128) { const size_t o = ((size_t)(b * 128 + row) * 2 + kh) * 64 + 8 * ch;
                const f32x4 k0 = *(const f32x4*)(a.in[2] + o), k1 = *(const f32x4*)(a.in[2] + o + 4), v0 = *(const f32x4*)(a.in[3] + o), v1 = *(const f32x4*)(a.in[3] + o + 4);
                kq = (u32x4){cvtpk(k0[0], k0[1]), cvtpk(k0[2], k0[3]), cvtpk(k1[0], k1[1]), cvtpk(k1[2], k1[3])};
                vq = (u32x4){cvtpk(v0[0], v0[1]), cvtpk(v0[2], v0[3]), cvtpk(v1[0], v1[1]), cvtpk(v1[2], v1[3])}; }
            else if (row < 144) { const bf16_t* p = H1 + (size_t)(MP + b * DS + (row - 128)) * EIN + 64 * kh + 8 * ch; kq = *(const u32x4*)(p + C_K); vq = *(const u32x4*)(p + C_V); }
        }
        *(LAS u32x4*)(lds + AT_KS + row * 128 + ((ch ^ (row & 7)) << 4)) = kq;
        LAS bf16_t* vt = (LAS bf16_t*)(lds + AT_VT) + row;
        const unsigned vw[4] = {vq.x, vq.y, vq.z, vq.w};
#pragma unroll
        for (int i = 0; i < 4; ++i) { vt[(8 * ch + 2 * i) * (AT_VTS / 2)] = (bf16_t)(vw[i] & 0xffffu); vt[(8 * ch + 2 * i + 1) * (AT_VTS / 2)] = (bf16_t)(vw[i] >> 16); }
    }
    __syncthreads();
    if (!SAMPLE || wave < 2) {
        const int ql = lane & 31, hi = lane >> 5;
        int qrow, head;
        if (!SAMPLE) { head = 4 * kh + (wave >> 1); qrow = b * SEQ + c * 64 + 32 * (wave & 1) + ql; }
        else { const int idx = 32 * wave + ql; head = 4 * kh + (idx >> 4); qrow = MP + b * DS + (idx & 15); }
        bf16x8 qf[4];
#pragma unroll
        for (int s = 0; s < 4; ++s) qf[s] = *(const bf16x8*)(H1 + (size_t)qrow * EIN + head * 64 + 16 * s + 8 * hi);
        const float sinkl = a.in[10][head] * LOG2E;
        f32x16 S[NKT];
        const int kt0 = SAMPLE ? 0 : (c >= 2 ? 0 : (2 - c) * 2);
#pragma unroll
        for (int kt = 0; kt < NKT; ++kt) {
            f32x16 acc = {};
#pragma unroll
            for (int s = 0; s < 4; ++s) {
                const bf16x8 kf = *(const LAS bf16x8*)(lds + AT_KS + (32 * kt + ql) * 128 + (((2 * s + hi) ^ (ql & 7)) << 4));
                acc = __builtin_amdgcn_mfma_f32_32x32x16_bf16(kf, qf[s], acc, 0, 0, 0);
            }
            if (!SAMPLE) { if (kt < kt0) {
#pragma unroll
                for (int r = 0; r < 16; ++r) acc[r] = -1e30f; } }
            else if (kt == NKT - 1) {
#pragma unroll
                for (int r = 8; r < 16; ++r) acc[r] = -1e30f; }
            S[kt] = acc;
        }
        float mx = sinkl;
#pragma unroll
        for (int kt = 0; kt < NKT; ++kt)
#pragma unroll
            for (int r = 0; r < 16; ++r) mx = fmaxf(mx, S[kt][r]);
        mx = fmaxf(mx, __shfl_xor(mx, 32));
        float ls = 0.f;
#pragma unroll
        for (int kt = 0; kt < NKT; ++kt)
#pragma unroll
            for (int r = 0; r < 16; ++r) { const float p = __builtin_amdgcn_exp2f(S[kt][r] - mx); S[kt][r] = p; ls += p; }
        ls += __shfl_xor(ls, 32);
        ls += __builtin_amdgcn_exp2f(sinkl - mx);
        const float inv = 1.0f / ls;
        f32x16 o[2] = {};
#pragma unroll
        for (int kt = 0; kt < NKT; ++kt)
#pragma unroll
            for (int s = 0; s < 2; ++s) {
                u32x4 pw; pw.x = cvtpk(S[kt][8 * s], S[kt][8 * s + 1]); pw.y = cvtpk(S[kt][8 * s + 2], S[kt][8 * s + 3]); pw.z = cvtpk(S[kt][8 * s + 4], S[kt][8 * s + 5]); pw.w = cvtpk(S[kt][8 * s + 6], S[kt][8 * s + 7]);
                const bf16x8 pf = __builtin_bit_cast(bf16x8, pw);
#pragma unroll
                for (int dt = 0; dt < 2; ++dt) {
                    const LAS unsigned char* vp = lds + AT_VT + (32 * dt + ql) * AT_VTS + (32 * kt + 16 * s + 4 * hi) * 2;
                    const u32x2 v0 = *(const LAS u32x2*)vp, v1 = *(const LAS u32x2*)(vp + 16);
                    const u32x4 vw = {v0.x, v0.y, v1.x, v1.y};
                    o[dt] = __builtin_amdgcn_mfma_f32_32x32x16_bf16(__builtin_bit_cast(bf16x8, vw), pf, o[dt], 0, 0, 0);
                }
            }
        bf16_t* orow = (bf16_t*)(a.ws + WS_AO) + (size_t)qrow * D + head * 64 + 4 * hi;
#pragma unroll
        for (int dt = 0; dt < 2; ++dt)
#pragma unroll
            for (int gq = 0; gq < 4; ++gq) {
                const u32x2 w = {cvtpk(o[dt][4 * gq] * inv, o[dt][4 * gq + 1] * inv), cvtpk(o[dt][4 * gq + 2] * inv, o[dt][4 * gq + 3] * inv)};
                *(u32x2*)(orow + 32 * dt + 8 * gq) = w;
            }
    }
    __syncthreads();
}

constexpr int LR_XC = 0;
constexpr int LR_XF = 16384;
constexpr int LR_A = 49152;
constexpr int LR_B = 81920;
constexpr int LR_SEG = 114688;
constexpr int LR_CAR = 118784;
template <bool APPLY, bool SAMPLE>
__device__ __forceinline__ void lru_unit(const Args& a, LAS unsigned char* lds, int b, int blk, int cg, int tid, int lane, int wave) {
    const bf16_t* H1 = (const bf16_t*)(a.ws + WS_H1);
    const int ch0 = 128 * cg;
    const size_t row0 = SAMPLE ? (size_t)(MP + b * DS) : (size_t)b * SEQ + (size_t)blk * 256;
    LAS float* XF = (LAS float*)(lds + LR_XF); LAS float* LA = (LAS float*)(lds + LR_A); LAS float* LB = (LAS float*)(lds + LR_B);
    LAS f32x2* SEG = (LAS f32x2*)(lds + LR_SEG); LAS float* CAR = (LAS float*)(lds + LR_CAR);
    const int ct = wave & 3, tt = wave >> 2, ql = lane & 31, hi = lane >> 5;
    const int nblk = 2 * cg + (ct >> 1), dofs = 32 * (ct & 1);
    bf16x8 wf[2][4];
#pragma unroll
    for (int gte = 0; gte < 2; ++gte)
#pragma unroll
        for (int s = 0; s < 4; ++s) wf[gte][s] = *(const bf16x8*)((const bf16_t*)(a.ws + WS_GATE) + (size_t)(gte * 8 + nblk) * 4096 + (dofs + ql) * 64 + 16 * s + 8 * hi);
    const int chw = ch0 + 32 * ct + ql;
    const float ba = a.in[14][chw], bx = a.in[16][chw], sp8 = ((const float*)(a.ws + WS_SP8))[chw];
    const int sch = tid & 127, seg = tid >> 7;
    float Aun = 1.f, Hun = 0.f;
    if (APPLY) {
        if (tid < 128) {
            float h;
            if (SAMPLE) h = a.in[4][b * DL + ch0 + tid];
            else { h = 0.f; const f32x2* cp = (const f32x2*)(a.ws + WS_CARRY) + (size_t)b * 32 * DL + ch0 + tid;
#pragma unroll 8
                for (int j = 0; j < 32; ++j) { const int jj = j < blk ? j : 0; const f32x2 ah = cp[(size_t)jj * DL]; const float A_ = j < blk ? ah.x : 1.f, H_ = j < blk ? ah.y : 0.f; h = A_ * h + H_; } }
            CAR[tid] = h;
        }
    }
    constexpr int NSUB = SAMPLE ? 1 : 4;
    for (int sc = 0; sc < NSUB; ++sc) {
        const int t0 = 64 * sc;
        for (int idx = tid; idx < 64 * 16; idx += NTHR) {
            const int tok = idx >> 4, c8 = idx & 15, ch = ch0 + 8 * c8;
            float xc[8];
            { const f32x4 b0 = *(const f32x4*)(a.in[12] + ch), b1 = *(const f32x4*)(a.in[12] + ch + 4);
              xc[0] = b0[0]; xc[1] = b0[1]; xc[2] = b0[2]; xc[3] = b0[3]; xc[4] = b1[0]; xc[5] = b1[1]; xc[6] = b1[2]; xc[7] = b1[3]; }
            const bool live = !SAMPLE || tok < DS;
#pragma unroll
            for (int i = 0; i < 4; ++i) {
                const int tl = t0 + tok - 3 + i;
                float xv[8];
                bool have = live;
                if (SAMPLE) {
                    if (tl < 0) { const float* p = a.in[5] + (size_t)(b * 3 + (3 + tl)) * DL + ch; const f32x4 p0 = *(const f32x4*)p, p1 = *(const f32x4*)(p + 4);
                        xv[0] = p0[0]; xv[1] = p0[1]; xv[2] = p0[2]; xv[3] = p0[3]; xv[4] = p1[0]; xv[5] = p1[1]; xv[6] = p1[2]; xv[7] = p1[3]; }
                    else { const u32x4 w = *(const u32x4*)(H1 + (row0 + (live ? tl : 0)) * EIN + C_XR + ch);
                        xv[0] = bflo(w.x); xv[1] = bfhi(w.x); xv[2] = bflo(w.y); xv[3] = bfhi(w.y); xv[4] = bflo(w.z); xv[5] = bfhi(w.z); xv[6] = bflo(w.w); xv[7] = bfhi(w.w); }
                } else {
                    const long tg = (long)blk * 256 + tl;
                    have = tg >= 0;
                    const u32x4 w = *(const u32x4*)(H1 + ((size_t)b * SEQ + (size_t)(have ? tg : 0)) * EIN + C_XR + ch);
                    xv[0] = bflo(w.x); xv[1] = bfhi(w.x); xv[2] = bflo(w.y); xv[3] = bfhi(w.y); xv[4] = bflo(w.z); xv[5] = bfhi(w.z); xv[6] = bflo(w.w); xv[7] = bfhi(w.w);
                }
                const f32x4 w0 = *(const f32x4*)(a.in[11] + i * DL + ch), w1 = *(const f32x4*)(a.in[11] + i * DL + ch + 4);
                const float wv[8] = {w0[0], w0[1], w0[2], w0[3], w1[0], w1[1], w1[2], w1[3]};
#pragma unroll
                for (int e = 0; e < 8; ++e) xc[e] += have ? xv[e] * wv[e] : 0.f;
            }
            if (!live) {
#pragma unroll
                for (int e = 0; e < 8; ++e) xc[e] = 0.f; }
            *(LAS f32x4*)(XF + tok * 128 + 8 * c8) = (f32x4){xc[0], xc[1], xc[2], xc[3]}; *(LAS f32x4*)(XF + tok * 128 + 8 * c8 + 4) = (f32x4){xc[4], xc[5], xc[6], xc[7]};
            *(LAS u32x4*)(lds + LR_XC + tok * 256 + ((c8 ^ (tok & 15)) << 4)) = (u32x4){cvtpk(xc[0], xc[1]), cvtpk(xc[2], xc[3]), cvtpk(xc[4], xc[5]), cvtpk(xc[6], xc[7])};
        }
        __syncthreads();
        {
            f32x16 ga = {}, gx = {};
#pragma unroll
            for (int s = 0; s < 4; ++s) {
                const int tok = 32 * tt + ql, c8 = 8 * (ct >> 1) + 2 * s + hi;
                const bf16x8 xa = *(const LAS bf16x8*)(lds + LR_XC + tok * 256 + ((c8 ^ (tok & 15)) << 4));
                ga = __builtin_amdgcn_mfma_f32_32x32x16_bf16(xa, wf[0][s], ga, 0, 0, 0);
                gx = __builtin_amdgcn_mfma_f32_32x32x16_bf16(xa, wf[1][s], gx, 0, 0, 0);
            }
#pragma unroll
            for (int r = 0; r < 16; ++r) {
                const int tok = 32 * tt + crow(r, hi), cl = 32 * ct + ql;
                const float rg = sigmoid_f(ga[r] + ba), ig = sigmoid_f(gx[r] + bx);
                const float la = -rg * sp8;
                const float av = __expf(la);
                const float bt = sqrtf(-expm1f(2.0f * la)) * (ig * XF[tok * 128 + cl]);
                LA[tok * 128 + cl] = av; LB[tok * 128 + cl] = bt;
            }
        }
        __syncthreads();
        if (!SAMPLE || seg == 0) {
            float P = 1.f, Hh = 0.f;
#pragma unroll
            for (int i = 0; i < 16; ++i) { const float av = LA[(16 * seg + i) * 128 + sch], bv = LB[(16 * seg + i) * 128 + sch]; Hh = av * Hh + bv; P *= av; }
            SEG[seg * 128 + sch] = (f32x2){P, Hh};
        }
        __syncthreads();
        if (!APPLY) {
            if (seg == 0) {
                float Ps = 1.f, Hs = 0.f;
#pragma unroll
                for (int s = 0; s < 4; ++s) { const f32x2 ph = SEG[s * 128 + sch]; Hs = ph.x * Hs + ph.y; Ps *= ph.x; }
                Hun = Ps * Hun + Hs; Aun *= Ps;
            }
        } else {
            if (!SAMPLE || seg == 0) {
                float h = CAR[sch];
#pragma unroll
                for (int s = 0; s < 3; ++s) if (s < seg) { const f32x2 ph = SEG[s * 128 + sch]; h = ph.x * h + ph.y; }
                const size_t rbase = row0 + (size_t)(SAMPLE ? 0 : t0) + 16 * seg;
                const bf16_t* gp = H1 + rbase * EIN + C_GR + ch0 + sch;
                bf16_t* op = (bf16_t*)(a.ws + WS_AO) + rbase * D + 512 + ch0 + sch;
#pragma unroll
                for (int i = 0; i < 16; ++i) {
                    const float av = LA[(16 * seg + i) * 128 + sch], bv = LB[(16 * seg + i) * 128 + sch];
                    h = av * h + bv;
                    const float gg = __uint_as_float((unsigned)gp[(size_t)i * EIN] << 16);
                    op[(size_t)i * D] = (bf16_t)(cvtpk(h * gg, 0.f) & 0xffffu);
                }
                if (SAMPLE) a.out[pg8::EpiIn::O_HS + (size_t)b * DL + ch0 + sch] = h;
                else if (seg == 3) { Hun = h; }
            }
            __syncthreads();
            if (!SAMPLE && seg == 3) CAR[sch] = Hun;
        }
        __syncthreads();
    }
    if (!APPLY) { if (seg == 0) ((f32x2*)(a.ws + WS_CARRY))[((size_t)b * 32 + blk) * DL + ch0 + sch] = (f32x2){Aun, Hun}; }
    else if (!SAMPLE && blk == 31 && seg == 3) a.out[pg8::EpiIn::O_HP + (size_t)b * DL + ch0 + sch] = Hun;
}

constexpr int GT_W = 0;
constexpr int GT_V = 32768;
constexpr int GT_ST = 65536;
constexpr int GT_VF = 66560;
__device__ __forceinline__ f32x2 ln_stats(const f32x2* lnp, int r) {
    const f32x4* p = (const f32x4*)(lnp + (size_t)r * 16); float s1 = 0.f, s2 = 0.f;
#pragma unroll
    for (int i = 0; i < 8; ++i) { const f32x4 v = p[i]; s1 += v[0] + v[2]; s2 += v[1] + v[3]; }
    const float mean = s1 * (1.0f / D), var = s2 * (1.0f / D) - mean * mean;
    return (f32x2){mean, __builtin_amdgcn_rsqf(fmaxf(var, 0.f) + EPS)};
}
__device__ __forceinline__ void gate_load_w(const Args& a, LAS unsigned char* lds, int g, int tid) {
    const bf16_t* W = (const bf16_t*)(a.ws + WS_SPW) + (size_t)g * 16384;
    for (int idx = tid; idx < 128 * 16; idx += NTHR) { const int t = idx >> 4, ch = idx & 15; *(LAS u32x4*)(lds + GT_W + t * 256 + ((ch ^ (t & 15)) << 4)) = *(const u32x4*)(W + t * 128 + 8 * ch); }
}
__device__ __forceinline__ void gate_unit(const Args& a, LAS unsigned char* lds, int j, int g, int tid, int lane, int wave) {
    const bf16_t* Z = (const bf16_t*)(a.ws + WS_Z);
    const f32x2* lnp = (const f32x2*)(a.ws + WS_LNP);
    LAS f32x2* ST = (LAS f32x2*)(lds + GT_ST);
    const size_t row0 = (size_t)j * 128;
    if (tid < 128) ST[tid] = ln_stats(lnp, (int)row0 + tid);
    __syncthreads();
    for (int idx = tid; idx < 128 * 16; idx += NTHR) {
        const int s = idx >> 4, cw = idx & 15;
        const u32x4 w = *(const u32x4*)(Z + (row0 + s) * 2048 + 1024 + g * 128 + 8 * cw);
        const f32x4 g0 = *(const f32x4*)(a.in[21] + g * 128 + 8 * cw), g1 = *(const f32x4*)(a.in[21] + g * 128 + 8 * cw + 4);
        const f32x2 st = ST[s];
        const float v[8] = {(bflo(w.x) - st.x) * st.y * g0[0], (bfhi(w.x) - st.x) * st.y * g0[1], (bflo(w.y) - st.x) * st.y * g0[2], (bfhi(w.y) - st.x) * st.y * g0[3],
                            (bflo(w.z) - st.x) * st.y * g1[0], (bfhi(w.z) - st.x) * st.y * g1[1], (bflo(w.w) - st.x) * st.y * g1[2], (bfhi(w.w) - st.x) * st.y * g1[3]};
#pragma unroll
        for (int i = 0; i < 8; ++i) { const int wv = 8 * cw + i; *(LAS bf16_t*)(lds + GT_V + wv * 256 + (((s >> 3) ^ (wv & 15)) << 4) + (s & 7) * 2) = (bf16_t)(cvtpk(v[i], 0.f) & 0xffffu); }
    }
    __syncthreads();
    const int wi = wave & 3, ql = lane & 31, hi = lane >> 5;
    const bf16_t* U = Z;
    bf16_t* O = (bf16_t*)(a.ws + WS_AO2);
#pragma unroll
    for (int q = 0; q < 2; ++q) {
        const int tj = (wave < 4) ? (q == 0 ? 0 : 3) : (q == 0 ? 1 : 2);
        f32x16 acc = {};
        for (int st = 0; st < 2 * (tj + 1); ++st) {
            const int wv = 32 * wi + ql, t = 32 * tj + ql, chk = 2 * st + hi;
            const bf16x8 af = *(const LAS bf16x8*)(lds + GT_V + wv * 256 + ((chk ^ (wv & 15)) << 4));
            const bf16x8 bf = *(const LAS bf16x8*)(lds + GT_W + t * 256 + ((chk ^ (t & 15)) << 4));
            acc = __builtin_amdgcn_mfma_f32_32x32x16_bf16(af, bf, acc, 0, 0, 0);
        }
        const int t = 32 * tj + ql; const float bs = a.in[23][g * 128 + t];
        const size_t r = row0 + t;
#pragma unroll
        for (int gq = 0; gq < 4; ++gq) {
            const int wv = 32 * wi + 8 * gq + 4 * hi;
            const u32x2 uw = *(const u32x2*)(U + r * 2048 + g * 128 + wv);
            const u32x2 ow = {cvtpk(bflo(uw.x) * (acc[4 * gq] + bs), bfhi(uw.x) * (acc[4 * gq + 1] + bs)), cvtpk(bflo(uw.y) * (acc[4 * gq + 2] + bs), bfhi(uw.y) * (acc[4 * gq + 3] + bs))};
            *(u32x2*)(O + r * D + g * 128 + wv) = ow;
        }
    }
    __syncthreads();
}
__device__ __forceinline__ void gate_unit_sample(const Args& a, LAS unsigned char* lds, int b, int g, int tid) {
    const bf16_t* Z = (const bf16_t*)(a.ws + WS_Z);
    const f32x2* lnp = (const f32x2*)(a.ws + WS_LNP);
    LAS float* VF = (LAS float*)(lds + GT_VF);
    const int t = tid >> 5, c4 = (tid & 31) * 4; const size_t r = (size_t)MP + b * DS + t;
    {
        const f32x2 st = ln_stats(lnp, (int)r);
        const u32x2 w = *(const u32x2*)(Z + r * 2048 + 1024 + g * 128 + c4);
        const f32x4 gv = *(const f32x4*)(a.in[21] + g * 128 + c4);
        const f32x4 v = {(bflo(w.x) - st.x) * st.y * gv[0], (bfhi(w.x) - st.x) * st.y * gv[1], (bflo(w.y) - st.x) * st.y * gv[2], (bfhi(w.y) - st.x) * st.y * gv[3]};
        *(LAS f32x4*)(VF + t * 128 + c4) = v;
        *(f32x4*)(a.out + pg8::EpiIn::O_GV + ((size_t)b * DS + t) * D + g * 128 + c4) = v;
    }
    __syncthreads();
    {
        const float bs = a.in[23][g * 128 + t];
        f32x4 sv = {bs, bs, bs, bs};
        const float* wrow = a.in[22] + ((size_t)g * 128 + t) * 128;
        for (int s = 0; s <= t; ++s) { const float w = wrow[s]; sv += w * *(const LAS f32x4*)(VF + s * 128 + c4); }
        const u32x2 uw = *(const u32x2*)(Z + r * 2048 + g * 128 + c4);
        const u32x2 ow = {cvtpk(bflo(uw.x) * sv[0], bfhi(uw.x) * sv[1]), cvtpk(bflo(uw.y) * sv[2], bfhi(uw.y) * sv[3])};
        *(u32x2*)((bf16_t*)(a.ws + WS_AO2) + r * D + g * 128 + c4) = ow;
    }
    __syncthreads();
}


namespace sg {
constexpr int P_OFF = 98304, RS_OFF = RING_BYTES + 1024;
template <int BMS, int BNS> struct Cfg { static constexpr int NT = (BMS / 32) * (BNS / 32), NKG = 8 / NT, KS = 8 / NKG, NCH = (BMS + BNS) * 16 / NTHR, BUF = (BMS + BNS) * 256; };
template <int BMS, int BNS>
__device__ __forceinline__ void load_c(LAS unsigned char* lds, int row, int c8, float (&v)[8]) {
    using C = Cfg<BMS, BNS>;
    const int tt = (row >> 5) * (BNS / 32) + (c8 >> 2);
    const LAS float* p = (const LAS float*)(lds + P_OFF + tt * 4096) + (row & 31) * 32 + (c8 & 3) * 8;
    f32x4 a = *(const LAS f32x4*)p, b = *(const LAS f32x4*)(p + 4);
#pragma unroll
    for (int kg = 1; kg < C::NKG; ++kg) { a += *(const LAS f32x4*)(p + kg * C::NT * 1024); b += *(const LAS f32x4*)(p + kg * C::NT * 1024 + 4); }
    v[0] = a[0]; v[1] = a[1]; v[2] = a[2]; v[3] = a[3]; v[4] = b[0]; v[5] = b[1]; v[6] = b[2]; v[7] = b[3];
}
__device__ __forceinline__ u32x4 pack8(const float (&o)[8]) { return (u32x4){cvtpk(o[0], o[1]), cvtpk(o[2], o[3]), cvtpk(o[4], o[5]), cvtpk(o[6], o[7])}; }
__device__ __forceinline__ void unpack8(const u32x4 w, float (&o)[8]) { o[0] = bflo(w.x); o[1] = bfhi(w.x); o[2] = bflo(w.y); o[3] = bfhi(w.y); o[4] = bflo(w.z); o[5] = bfhi(w.z); o[6] = bflo(w.w); o[7] = bfhi(w.w); }

struct SIn {
    bf16_t* H1; const float* rs0; const f32x4* rope; const float* qg; const float* kg; float* out;
    __device__ __forceinline__ void prep(LAS unsigned char*, int, int) const {}
    __device__ __forceinline__ void item(LAS unsigned char* lds, int tm, int tn, int row, int c8, const float (&v)[8]) const {
        const int rr = tm * 64 + row, r = MP + rr, b = rr >> 4, t = rr & 15; const float rs = rs0[r];
        const int kind = tn < 8 ? 0 : (tn < 10 ? 1 : (tn < 12 ? 2 : (tn < 20 ? 3 : 4)));
        float o[8];
        if (kind <= 1) {
            float ss = 0.f;
#pragma unroll
            for (int e = 0; e < 8; ++e) { const float x = v[e] * rs; ss += x * x; }
            ss += __shfl_xor(ss, 1); ss += __shfl_xor(ss, 2); ss += __shfl_xor(ss, 4);
            const float sc = rs * __builtin_amdgcn_rsqf(ss * (1.0f / 64.0f) + EPS);
            float pv[8]; load_c<64, 64>(lds, row, c8 ^ 4, pv);
            const float* g = kind == 0 ? qg : kg; const int d0 = 8 * c8, dp = 8 * (c8 ^ 4);
            const f32x4* cs = rope + (size_t)(PAST + t) * 16 + (d0 & 31) / 2;
            const f32x4 g0 = *(const f32x4*)(g + d0), g1 = *(const f32x4*)(g + d0 + 4), h0 = *(const f32x4*)(g + dp), h1 = *(const f32x4*)(g + dp + 4);
            const float go[8] = {g0[0], g0[1], g0[2], g0[3], g1[0], g1[1], g1[2], g1[3]}, gp[8] = {h0[0], h0[1], h0[2], h0[3], h1[0], h1[1], h1[2], h1[3]};
            const float sgn = c8 < 4 ? -1.f : 1.f;
#pragma unroll
            for (int q = 0; q < 4; ++q) { const f32x4 c = cs[q];
                { const float xo = v[2 * q] * sc * go[2 * q], xp = pv[2 * q] * sc * gp[2 * q]; o[2 * q] = xo * c[0] + sgn * xp * c[1]; }
                { const float xo = v[2 * q + 1] * sc * go[2 * q + 1], xp = pv[2 * q + 1] * sc * gp[2 * q + 1]; o[2 * q + 1] = xo * c[2] + sgn * xp * c[3]; } }
        } else if (kind == 4) {
#pragma unroll
            for (int e = 0; e < 8; ++e) o[e] = gelu_t(v[e] * rs);
        } else {
#pragma unroll
            for (int e = 0; e < 8; ++e) o[e] = v[e] * rs;
        }
        float ob[8]; const float qs = kind == 0 ? SCQ : 1.0f;
#pragma unroll
        for (int e = 0; e < 8; ++e) ob[e] = o[e] * qs;
        *(u32x4*)(H1 + (size_t)r * EIN + 64 * tn + 8 * c8) = pack8(ob);
        float* dst = nullptr;
        if (kind == 1 || kind == 2) dst = out + (kind == 1 ? pg8::EpiIn::O_KS : pg8::EpiIn::O_VS) + ((size_t)(b * 128 + 112 + t) * 2 + (tn & 1)) * 64 + 8 * c8;
        else if (kind == 3 && t >= DS - 3) dst = out + pg8::EpiIn::O_CS + (size_t)(b * 3 + (t - (DS - 3))) * 512 + (tn - 12) * 64 + 8 * c8;
        if (dst) { *(f32x4*)dst = (f32x4){o[0], o[1], o[2], o[3]}; *(f32x4*)(dst + 4) = (f32x4){o[4], o[5], o[6], o[7]}; }
    }
};
template <bool RES_F32> struct SRes {
    const float* xs; const bf16_t* rb; bf16_t* Y; float* ssq;
    __device__ __forceinline__ void prep(LAS unsigned char*, int, int) const {}
    __device__ __forceinline__ void item(LAS unsigned char*, int tm, int tn, int row, int c8, const float (&v)[8]) const {
        const int rr = tm * 32 + row, r = MP + rr, col = 64 * tn + 8 * c8; float res[8];
        if (RES_F32) { const f32x4 a = *(const f32x4*)(xs + (size_t)rr * D + col), b = *(const f32x4*)(xs + (size_t)rr * D + col + 4); res[0] = a[0]; res[1] = a[1]; res[2] = a[2]; res[3] = a[3]; res[4] = b[0]; res[5] = b[1]; res[6] = b[2]; res[7] = b[3]; }
        else unpack8(*(const u32x4*)(rb + (size_t)r * D + col), res);
        float y[8], s = 0.f;
#pragma unroll
        for (int e = 0; e < 8; ++e) { y[e] = res[e] + v[e]; s += y[e] * y[e]; }
        s += __shfl_xor(s, 1); s += __shfl_xor(s, 2); s += __shfl_xor(s, 4);
        if (c8 == 0) ssq[(size_t)r * 16 + tn] = s;
        *(u32x4*)(Y + (size_t)r * D + col) = pack8(y);
    }
};
template <int ACT, int BMS, int BNS> struct SAct {
    const float* ssq; bf16_t* O; int ldc; f32x2* lnp;
    __device__ __forceinline__ void prep(LAS unsigned char* lds, int tm, int tid) const { if (tid < BMS) ((LAS float*)(lds + RS_OFF))[tid] = pg8::row_rs(ssq, MP + tm * BMS + tid); }
    __device__ __forceinline__ void item(LAS unsigned char* lds, int tm, int tn, int row, int c8, const float (&v)[8]) const {
        const int r = MP + tm * BMS + row, col = BNS * tn + 8 * c8; const float rs = ((const LAS float*)(lds + RS_OFF))[row];
        float o[8], s1 = 0.f, s2 = 0.f;
#pragma unroll
        for (int e = 0; e < 8; ++e) { const float x = v[e] * rs; if (ACT == 0) { const float a = fmaxf(x, 0.f); o[e] = a * a; } else { o[e] = gelu_t(x); s1 += o[e]; s2 += o[e] * o[e]; } }
        *(u32x4*)(O + (size_t)r * ldc + col) = pack8(o);
        if (ACT == 1) { s1 += __shfl_xor(s1, 1); s1 += __shfl_xor(s1, 2); s1 += __shfl_xor(s1, 4); s2 += __shfl_xor(s2, 1); s2 += __shfl_xor(s2, 2); s2 += __shfl_xor(s2, 4);
            if ((c8 & 7) == 0 && col >= 1024) lnp[(size_t)r * 16 + (col >> 6) - 16] = (f32x2){s1, s2}; }
    }
};
struct SOut {
    const bf16_t* rb; float* out;
    __device__ __forceinline__ void prep(LAS unsigned char*, int, int) const {}
    __device__ __forceinline__ void item(LAS unsigned char*, int tm, int tn, int row, int c8, const float (&v)[8]) const {
        const int r = MP + tm * 32 + row, col = 64 * tn + 8 * c8; float res[8]; unpack8(*(const u32x4*)(rb + (size_t)r * D + col), res);
        float* dst = out + (size_t)r * D + col;
        *(f32x4*)dst = (f32x4){res[0] + v[0], res[1] + v[1], res[2] + v[2], res[3] + v[3]}; *(f32x4*)(dst + 4) = (f32x4){res[4] + v[4], res[5] + v[5], res[6] + v[6], res[7] + v[7]};
    }
};

template <int BMS, int BNS, class Epi>
__device__ __forceinline__ void small_gemm(LAS unsigned char* lds, const bf16_t* A, const bf16_t* Bt, int N, int K, int t_first, int t_stride, const Epi& E, int tid, int lane, int wave) {
    using C = Cfg<BMS, BNS>;
    constexpr int NTM = MS / BMS; const int ntiles = NTM * (N / BNS), nk = K / 128;
    const int ql = lane & 31, hi = lane >> 5;
    const int tt = wave % C::NT, kg = wave / C::NT, mt = tt / (BNS / 32), nt = tt % (BNS / 32);
    for (int tile = t_first; tile < ntiles; tile += t_stride) {
        const int tm = tile % NTM, tn = tile / NTM;
        E.prep(lds, tm, tid);
        const bf16_t* srcp[C::NCH]; unsigned dst[C::NCH];
#pragma unroll
        for (int i = 0; i < C::NCH; ++i) { const int q = tid + NTHR * i, row = q >> 4, pos = q & 15;
            srcp[i] = (row < BMS ? A + (size_t)(MP + tm * BMS + row) * K : Bt + (size_t)(tn * BNS + row - BMS) * K) + pos * 8;
            dst[i] = (unsigned)(row * 256 + ((pos ^ (row & 15)) << 4)); }
        u32x4 stg[C::NCH];
#pragma unroll
        for (int i = 0; i < C::NCH; ++i) stg[i] = *(const u32x4*)(srcp[i]);
#pragma unroll
        for (int i = 0; i < C::NCH; ++i) *(LAS u32x4*)(lds + dst[i]) = stg[i];
        __syncthreads();
        f32x16 acc = {};
        for (int ks = 0; ks < nk; ++ks) {
            const bool more = ks + 1 < nk;
            if (more) {
#pragma unroll
                for (int i = 0; i < C::NCH; ++i) stg[i] = *(const u32x4*)(srcp[i] + (size_t)(ks + 1) * 128); }
            const LAS unsigned char* base = lds + (ks & 1) * C::BUF;
#pragma unroll
            for (int s = 0; s < C::KS; ++s) {
                const int sk = kg * C::KS + s, arow = 32 * mt + ql, brow = BMS + 32 * nt + ql;
                const bf16x8 af = *(const LAS bf16x8*)(base + arow * 256 + (((2 * sk + hi) ^ (ql & 15)) << 4));
                const bf16x8 bf = *(const LAS bf16x8*)(base + brow * 256 + (((2 * sk + hi) ^ (ql & 15)) << 4));
                acc = __builtin_amdgcn_mfma_f32_32x32x16_bf16(af, bf, acc, 0, 0, 0);
            }
            if (more) {
#pragma unroll
                for (int i = 0; i < C::NCH; ++i) *(LAS u32x4*)(lds + ((ks + 1) & 1) * C::BUF + dst[i]) = stg[i]; }
            __syncthreads();
        }
        { LAS float* P = (LAS float*)(lds + P_OFF + wave * 4096);
#pragma unroll
          for (int r = 0; r < 16; ++r) P[crow(r, hi) * 32 + ql] = acc[r]; }
        __syncthreads();
        constexpr int NIT = BMS * BNS / 8, CPR = BNS / 8;
        for (int q = tid; q < NIT; q += NTHR) { const int row = q / CPR, c8 = q % CPR; float v[8]; load_c<BMS, BNS>(lds, row, c8, v); E.item(lds, tm, tn, row, c8, v); }
        __syncthreads();
    }
}
}

__global__ void __launch_bounds__(NTHR, 2) mk_fwd(Args args) {
    extern __shared__ __attribute__((aligned(16))) unsigned char lds_raw[];
    LAS unsigned char* lds = (LAS unsigned char*)lds_raw;
    volatile LAS unsigned* MISC = (volatile LAS unsigned*)(lds + MISC_OFF);
    const int tid = threadIdx.x, lane = tid & 63, wave = __builtin_amdgcn_readfirstlane(tid >> 6);
    const int G = gridDim.x; const int bx = blockIdx.x; const int vcu = (G % 8 == 0) ? (bx % 8) * (G / 8) + bx / 8 : bx;
    gu32* ctl = (gu32*)(args.ws + WS_CTL);
    for (int u = tid; u < (LDS_BYTES - LDSCTL_OFF) / 4; u += NTHR) ((LAS unsigned*)(lds + LDSCTL_OFF))[u] = 0u;
    __syncthreads();
    XcdBarrier bar; bar.bar = (unsigned*)(ctl + CW_BAR) + args.li * XCD_BAR_WORDS; bar.x = 0; bar.st = nullptr;
    if (N_LAUNCHES != PER_PHASE) bar = xcd_barrier_post((unsigned*)(ctl + CW_BAR) + args.li * XCD_BAR_WORDS, MISC + 8);
#define GRID_BAR() do { if (N_LAUNCHES != PER_PHASE) xcd_barrier(bar); } while (0)
    const int lo = args.ph_lo, hi_ = args.ph_hi;
#define IN(k) (lo <= (k) && (k) < hi_)
#define BOTH(k) (IN(k) && IN((k) + 1))
    unsigned char* ws = args.ws;
    bf16_t* YA = (bf16_t*)(ws + WS_YA); bf16_t* YB = (bf16_t*)(ws + WS_YB); bf16_t* HID = (bf16_t*)(ws + WS_BIG);
    float* SSQ = (float*)(ws + WS_SSQ);

    if (IN(0)) { p0_prologue(args, lds, vcu, G, tid, lane, wave); if (BOTH(0)) GRID_BAR(); }

    if (IN(1)) {
        pg8::Gemm g{(const bf16_t*)(ws + WS_XB), (const bf16_t*)(ws + WS_WIN_E), MP, EIN, D}; pg8::StaticOrder S; S.init(MP, EIN, G, bx);
        pg8::EpiIn E{(bf16_t*)(ws + WS_H1), (const float*)(ws + WS_RS0), (const f32x4*)(ws + WS_ROPE), args.in[8], args.in[9], args.out};
        pg8::gemm_phase<pg8::EpiIn, pg8::StaticOrder, true, true>(lds + RING_OFF, g, S, E);
        { sg::SIn SE{(bf16_t*)(ws + WS_H1), (const float*)(ws + WS_RS0), (const f32x4*)(ws + WS_ROPE), args.in[8], args.in[9], args.out};
          const bool idle = (G == 256); sg::small_gemm<64, 64>(lds, (const bf16_t*)(ws + WS_XB), (const bf16_t*)(ws + WS_WIN_E), EIN, D, idle ? (bx >= 192 ? bx - 192 : 1 << 20) : vcu, idle ? 64 : G, SE, tid, lane, wave); }
        if (BOTH(1)) GRID_BAR();
    }
    if (IN(2)) {
        for (int u = vcu; u < 256; u += G) lru_unit<false, false>(args, lds, u >> 7, (u >> 2) & 31, u & 3, tid, lane, wave);
        __syncthreads();
        for (int u = vcu; u < 512; u += G) attn_unit<false>(args, lds, u >> 8, (u >> 1) & 127, u & 1, tid, lane, wave);
        for (int u = vcu; u < 64; u += G) attn_unit<true>(args, lds, u >> 1, 0, u & 1, tid, lane, wave);
        for (int u = vcu - 64; u >= 0 && u < 128; u += G) lru_unit<true, true>(args, lds, u >> 2, 0, u & 3, tid, lane, wave);
        if (BOTH(2)) GRID_BAR();
    }
    if (IN(3)) {
        for (int u = vcu; u < 256; u += G) lru_unit<true, false>(args, lds, u >> 7, (u >> 2) & 31, u & 3, tid, lane, wave);
        if (BOTH(3)) GRID_BAR();
    }
    if (IN(4)) {
        pg8::Gemm g{(const bf16_t*)(ws + WS_AO), (const bf16_t*)(ws + WS_WOUT_E), MP, D, D}; pg8::StaticOrder S; S.init(MP, D, G, bx);
        pg8::EpiRes<true> E{args.in[0], args.in[1], nullptr, YA, SSQ};
        pg8::gemm_phase<pg8::EpiRes<true>, pg8::StaticOrder, true, true>(lds + RING_OFF, g, S, E);
        { sg::SRes<true> SE{args.in[1], nullptr, YA, SSQ}; sg::small_gemm<32, 64>(lds, (const bf16_t*)(ws + WS_AO), (const bf16_t*)(ws + WS_WOUT_E), D, D, vcu, G, SE, tid, lane, wave); }
        if (BOTH(4)) GRID_BAR();
    }
    if (IN(5)) {
        pg8::Gemm g{YA, (const bf16_t*)(ws + WS_W1A), MP, FF, D}; pg8::StaticOrder S; S.init(MP, FF, G, bx);
        pg8::EpiAct<0> E{SSQ, HID, FF, nullptr};
        pg8::gemm_phase<pg8::EpiAct<0>, pg8::StaticOrder, true, true>(lds + RING_OFF, g, S, E);
        { sg::SAct<0, 64, 128> SE{SSQ, HID, FF, nullptr}; sg::small_gemm<64, 128>(lds, YA, (const bf16_t*)(ws + WS_W1A), FF, D, vcu, G, SE, tid, lane, wave); }
        if (BOTH(5)) GRID_BAR();
    }
    if (IN(6)) {
        pg8::Gemm g{HID, (const bf16_t*)(ws + WS_W2A), MP, D, FF}; pg8::StaticOrder S; S.init(MP, D, G, bx);
        pg8::EpiRes<false> E{nullptr, nullptr, YA, YB, SSQ};
        pg8::gemm_phase<pg8::EpiRes<false>, pg8::StaticOrder, true, true>(lds + RING_OFF, g, S, E);
        { sg::SRes<false> SE{nullptr, YA, YB, SSQ}; sg::small_gemm<32, 64>(lds, HID, (const bf16_t*)(ws + WS_W2A), D, FF, vcu, G, SE, tid, lane, wave); }
        if (BOTH(6)) GRID_BAR();
    }
    if (IN(7)) {
        pg8::Gemm g{YB, (const bf16_t*)(ws + WS_WIN_O), MP, 2 * D, D}; pg8::StaticOrder S; S.init(MP, 2 * D, G, bx);
        pg8::EpiAct<1> E{SSQ, (bf16_t*)(ws + WS_Z), 2 * D, (f32x2*)(ws + WS_LNP)};
        pg8::gemm_phase<pg8::EpiAct<1>, pg8::StaticOrder, true, true>(lds + RING_OFF, g, S, E);
        { sg::SAct<1, 64, 64> SE{SSQ, (bf16_t*)(ws + WS_Z), 2 * D, (f32x2*)(ws + WS_LNP)}; sg::small_gemm<64, 64>(lds, YB, (const bf16_t*)(ws + WS_WIN_O), 2 * D, D, vcu, G, SE, tid, lane, wave); }
        if (BOTH(7)) GRID_BAR();
    }
    if (IN(8)) {
        const int g = vcu & 7;
        gate_load_w(args, lds, g, tid);
        __syncthreads();
        for (int j = vcu >> 3; j < 128; j += G / 8) gate_unit(args, lds, j, g, tid, lane, wave);
        for (int u = vcu; u < 256; u += G) gate_unit_sample(args, lds, u >> 3, u & 7, tid);
        if (BOTH(8)) GRID_BAR();
    }
    if (IN(9)) {
        pg8::Gemm g{(const bf16_t*)(ws + WS_AO2), (const bf16_t*)(ws + WS_WOUT_O), MP, D, D}; pg8::StaticOrder S; S.init(MP, D, G, bx);
        pg8::EpiRes<false> E{nullptr, nullptr, YB, YA, SSQ};
        pg8::gemm_phase<pg8::EpiRes<false>, pg8::StaticOrder, true, true>(lds + RING_OFF, g, S, E);
        { sg::SRes<false> SE{nullptr, YB, YA, SSQ}; sg::small_gemm<32, 64>(lds, (const bf16_t*)(ws + WS_AO2), (const bf16_t*)(ws + WS_WOUT_O), D, D, vcu, G, SE, tid, lane, wave); }
        if (BOTH(9)) GRID_BAR();
    }
    if (IN(10)) {
        pg8::Gemm g{YA, (const bf16_t*)(ws + WS_W1B), MP, FF, D}; pg8::StaticOrder S; S.init(MP, FF, G, bx);
        pg8::EpiAct<0> E{SSQ, HID, FF, nullptr};
        pg8::gemm_phase<pg8::EpiAct<0>, pg8::StaticOrder, true, true>(lds + RING_OFF, g, S, E);
        { sg::SAct<0, 64, 128> SE{SSQ, HID, FF, nullptr}; sg::small_gemm<64, 128>(lds, YA, (const bf16_t*)(ws + WS_W1B), FF, D, vcu, G, SE, tid, lane, wave); }
        if (BOTH(10)) GRID_BAR();
    }
    if (IN(11)) {
        pg8::Gemm g{HID, (const bf16_t*)(ws + WS_W2B), MP, D, FF}; pg8::StaticOrder S; S.init(MP, D, G, bx);
        pg8::EpiOut E{YA, args.out};
        pg8::gemm_phase<pg8::EpiOut, pg8::StaticOrder, true, true>(lds + RING_OFF, g, S, E);
        { sg::SOut SE{YA, args.out}; sg::small_gemm<32, 64>(lds, HID, (const bf16_t*)(ws + WS_W2B), D, FF, vcu, G, SE, tid, lane, wave); }
    }
#undef IN
#undef BOTH
#undef GRID_BAR
}

extern "C" void kernel_launch(void* const* d_in, const int* in_sizes, int n_in, void* d_out, int out_size, void* d_ws, size_t ws_size, hipStream_t stream) {
    static int grid = 0;
    if (grid == 0) {
        if (n_in != 28 || ws_size < WS_END) { fprintf(stderr, "kernel_launch: expected 28 inputs and >= %zu bytes of workspace; got %d, %zu\n", (size_t)WS_END, n_in, ws_size); grid = -1; return; }
        int dev = 0, cus = 0, per_cu = 0;
        if (hipGetDevice(&dev) != hipSuccess || hipDeviceGetAttribute(&cus, hipDeviceAttributeMultiprocessorCount, dev) != hipSuccess) { grid = -1; return; }
        if (hipFuncSetAttribute((const void*)mk_fwd, hipFuncAttributeMaxDynamicSharedMemorySize, LDS_BYTES) != hipSuccess) { fprintf(stderr, "kernel_launch: hipFuncSetAttribute failed\n"); grid = -1; return; }
        if (hipOccupancyMaxActiveBlocksPerMultiprocessor(&per_cu, (const void*)mk_fwd, NTHR, LDS_BYTES) != hipSuccess || per_cu < 1) fprintf(stderr, "kernel_launch: occupancy query reports %d\n", per_cu);
        (void)hipGetLastError();
        grid = cus;
        if (grid > 256) grid = 256;
        grid &= ~7;
    }
    if (grid <= 0) return;
    (void)hipMemsetAsync((char*)d_ws + WS_CTL, 0, CTL_ZERO_BYTES, stream);
    Args a{};
    for (int i = 0; i < 28; ++i) a.in[i] = (const float*)d_in[i];
    a.out = (float*)d_out; a.ws = (unsigned char*)d_ws;
    if (N_LAUNCHES == 1) { a.ph_lo = 0; a.ph_hi = PER_PHASE; a.li = 0; hipLaunchKernelGGL(mk_fwd, dim3(grid), dim3(NTHR), LDS_BYTES, stream, a); }
    else { for (int li = 0; li < PER_PHASE; ++li) { a.ph_lo = li; a.ph_hi = li + 1; a.li = 0; hipLaunchKernelGGL(mk_fwd, dim3(grid), dim3(NTHR), LDS_BYTES, stream, a); } }
}
```
